# Optimizing an MI355X kernel written in HIP

```python
import jax, jax.numpy as jnp
from jax import lax
import numpy as np

D_MODEL = 1024
BATCH = 8
SEQ = 4096
DEPTH = 4

HEAD_DIM = 64
SB_HEADS = D_MODEL // HEAD_DIM
SW_Q_HEADS = D_MODEL // HEAD_DIM
SW_KV_HEADS = max(1, SW_Q_HEADS // 8)
SW_GROUP = SW_Q_HEADS // SW_KV_HEADS
SW_IN = (SW_Q_HEADS + 2 * SW_KV_HEADS) * HEAD_DIM
WINDOW = 128
BLOCK = 128
ROPE_THETA = 500000.0
ROT_DIM = HEAD_DIM // 4
D_FF = ((8 * D_MODEL // 3 + 255) // 256) * 256
N_MIXERS = 2
N_SB_LAYERS = (DEPTH + 1) // 2
N_SW_LAYERS = DEPTH // 2
EPS = 1e-6

kernel_name = 'hybrid_stickbreak_swa_macaron'


def rms_norm(x, gain):
    xf = x.astype(jnp.float32)
    y = xf * lax.rsqrt(jnp.mean(xf * xf, axis=-1, keepdims=True) + EPS)
    return (y * gain.astype(jnp.float32)).astype(x.dtype)


def swiglu(h, w_gate_up, w_down):
    gate, up = jnp.split(h @ w_gate_up, 2, axis=-1)
    return (jax.nn.silu(gate) * up) @ w_down


def rope_angles(positions):
    inv_freq = ROPE_THETA ** (-jnp.arange(0, ROT_DIM, 2, dtype=jnp.float32) / ROT_DIM)
    ang = positions.astype(jnp.float32)[..., None] * inv_freq
    return jnp.cos(ang), jnp.sin(ang)


def apply_partial_rope(x, cos, sin):
    half = ROT_DIM // 2
    x1 = x[..., :half].astype(jnp.float32)
    x2 = x[..., half:ROT_DIM].astype(jnp.float32)
    rot = jnp.concatenate([x1 * cos - x2 * sin, x2 * cos + x1 * sin], axis=-1).astype(x.dtype)
    return jnp.concatenate([rot, x[..., ROT_DIM:]], axis=-1)


def stick_breaking_attention(h, w_in, w_out):
    b, s, _ = h.shape
    q, k, v = jnp.split(h @ w_in, 3, axis=-1)
    q = q.reshape(b, s, SB_HEADS, HEAD_DIM).transpose(0, 2, 1, 3)
    k = k.reshape(b, s, SB_HEADS, HEAD_DIM).transpose(0, 2, 1, 3)
    v = v.reshape(b, s, SB_HEADS, HEAD_DIM).transpose(0, 2, 1, 3)
    scale = HEAD_DIM ** -0.5
    outs = []
    for blk in range(s // BLOCK):
        t0 = blk * BLOCK
        kv_len = t0 + BLOCK
        qb = q[:, :, t0:kv_len]
        kb = k[:, :, :kv_len]
        vb = v[:, :, :kv_len]
        z = jnp.einsum('bhtd,bhsd->bhts', qb, kb).astype(jnp.float32) * scale
        causal = (np.arange(kv_len)[None, :] < (t0 + np.arange(BLOCK))[:, None])
        log_beta = jax.nn.log_sigmoid(z)
        log_keep = jnp.where(causal, log_beta - z, 0.0)
        later = lax.cumsum(log_keep, axis=3, reverse=True) - log_keep
        weights = jnp.where(causal, jnp.exp(log_beta + later), 0.0)
        outs.append(jnp.einsum('bhts,bhsd->bhtd', weights.astype(vb.dtype), vb))
    o = jnp.concatenate(outs, axis=2).transpose(0, 2, 1, 3).reshape(b, s, SB_HEADS * HEAD_DIM)
    return o @ w_out


def sliding_window_attention(h, positions, w_in, w_out, q_gain, k_gain, sinks):
    b, s, _ = h.shape
    nb = s // BLOCK
    qkv = h @ w_in
    nq = SW_Q_HEADS * HEAD_DIM
    nk = SW_KV_HEADS * HEAD_DIM
    q = qkv[..., :nq].reshape(b, s, SW_KV_HEADS, SW_GROUP, HEAD_DIM)
    k = qkv[..., nq:nq + nk].reshape(b, s, SW_KV_HEADS, HEAD_DIM)
    v = qkv[..., nq + nk:].reshape(b, s, SW_KV_HEADS, HEAD_DIM)
    q = rms_norm(q, q_gain)
    k = rms_norm(k, k_gain)
    cos, sin = rope_angles(positions)
    q = apply_partial_rope(q, cos[:, :, None, None, :], sin[:, :, None, None, :])
    k = apply_partial_rope(k, cos[:, :, None, :], sin[:, :, None, :])
    pad = jnp.zeros((b, BLOCK, SW_KV_HEADS, HEAD_DIM), k.dtype)
    k_pad = jnp.concatenate([pad, k], axis=1).reshape(b, nb + 1, BLOCK, SW_KV_HEADS, HEAD_DIM)
    v_pad = jnp.concatenate([pad, v], axis=1).reshape(b, nb + 1, BLOCK, SW_KV_HEADS, HEAD_DIM)
    k_band = jnp.concatenate([k_pad[:, :-1], k_pad[:, 1:]], axis=2)
    v_band = jnp.concatenate([v_pad[:, :-1], v_pad[:, 1:]], axis=2)
    qb = q.reshape(b, nb, BLOCK, SW_KV_HEADS, SW_GROUP, HEAD_DIM)
    scores = jnp.einsum('bntkgd,bnskd->bnkgts', qb, k_band).astype(jnp.float32) * (HEAD_DIM ** -0.5)
    blk_start = np.arange(nb)[:, None, None] * BLOCK
    q_pos = blk_start + np.arange(BLOCK)[None, :, None]
    k_pos = blk_start - BLOCK + np.arange(2 * BLOCK)[None, None, :]
    mask = (k_pos >= 0) & (k_pos <= q_pos) & (q_pos - k_pos < WINDOW)
    scores = jnp.where(mask[None, :, None, None], scores, -jnp.inf)
    sink = sinks.astype(jnp.float32).reshape(SW_KV_HEADS, SW_GROUP)[None, None, :, :, None, None]
    m = jnp.maximum(jnp.max(scores, axis=-1, keepdims=True), sink)
    p = jnp.exp(scores - m)
    probs = p / (jnp.sum(p, axis=-1, keepdims=True) + jnp.exp(sink - m))
    o = jnp.einsum('bnkgts,bnskd->bntkgd', probs.astype(v_band.dtype), v_band)
    return o.reshape(b, s, SW_Q_HEADS * HEAD_DIM) @ w_out


def setup_inputs(seed: int = 0) -> dict:
    key = jax.random.key(seed)
    ks = jax.random.split(key, 14)
    f32 = jnp.float32
    x = jax.random.normal(ks[0], (BATCH, SEQ, D_MODEL), f32)
    offsets = jax.random.randint(ks[1], (BATCH, 1), 0, 1024, dtype=jnp.int32)
    positions = offsets + jnp.arange(SEQ, dtype=jnp.int32)[None, :]
    norm_gains = 1.0 + 0.02 * jax.random.normal(ks[2], (DEPTH, 3, D_MODEL), f32)
    ffn_w_gate_up = jax.random.normal(ks[3], (DEPTH, 2, D_MODEL, 2 * D_FF), f32) * D_MODEL ** -0.5
    ffn_w_down = jax.random.normal(ks[4], (DEPTH, 2, D_FF, D_MODEL), f32) * D_FF ** -0.5
    sb_w_in = jax.random.normal(ks[5], (N_SB_LAYERS, D_MODEL, 3 * SB_HEADS * HEAD_DIM), f32) * D_MODEL ** -0.5
    sb_w_out = jax.random.normal(ks[6], (N_SB_LAYERS, SB_HEADS * HEAD_DIM, D_MODEL), f32) * (SB_HEADS * HEAD_DIM) ** -0.5
    sw_w_in = jax.random.normal(ks[7], (N_SW_LAYERS, D_MODEL, SW_IN), f32) * D_MODEL ** -0.5
    sw_w_out = jax.random.normal(ks[8], (N_SW_LAYERS, SW_Q_HEADS * HEAD_DIM, D_MODEL), f32) * (SW_Q_HEADS * HEAD_DIM) ** -0.5
    sw_q_gain = 1.0 + 0.02 * jax.random.normal(ks[9], (N_SW_LAYERS, HEAD_DIM), f32)
    sw_k_gain = 1.0 + 0.02 * jax.random.normal(ks[10], (N_SW_LAYERS, HEAD_DIM), f32)
    sw_sinks = 0.5 * jax.random.normal(ks[11], (N_SW_LAYERS, SW_Q_HEADS), f32)
    return {'x': x, 'positions': positions, 'norm_gains': norm_gains,
            'ffn_w_gate_up': ffn_w_gate_up, 'ffn_w_down': ffn_w_down,
            'sb_w_in': sb_w_in, 'sb_w_out': sb_w_out,
            'sw_w_in': sw_w_in, 'sw_w_out': sw_w_out,
            'sw_q_gain': sw_q_gain, 'sw_k_gain': sw_k_gain, 'sw_sinks': sw_sinks}


def reference(x, positions, norm_gains, ffn_w_gate_up, ffn_w_down, sb_w_in, sb_w_out,
              sw_w_in, sw_w_out, sw_q_gain, sw_k_gain, sw_sinks):
    for i in range(DEPTH):
        slot = i // N_MIXERS
        x = x + 0.5 * swiglu(rms_norm(x, norm_gains[i, 0]), ffn_w_gate_up[i, 0], ffn_w_down[i, 0])
        h = rms_norm(x, norm_gains[i, 1])
        if i % N_MIXERS == 0:
            x = x + stick_breaking_attention(h, sb_w_in[slot], sb_w_out[slot])
        else:
            x = x + sliding_window_attention(h, positions, sw_w_in[slot], sw_w_out[slot],
                                             sw_q_gain[slot], sw_k_gain[slot], sw_sinks[slot])
        x = x + 0.5 * swiglu(rms_norm(x, norm_gains[i, 2]), ffn_w_gate_up[i, 1], ffn_w_down[i, 1])
    return x
```

```cpp
#include <hip/hip_runtime.h>
#include <hip/hip_cooperative_groups.h>
#include <cstdio>
#include <cstdint>
namespace cg = cooperative_groups;
namespace pg8 {
#define PG8_LAS __attribute__((address_space(3)))
typedef unsigned short bf16_t;
typedef short bf16x8 __attribute__((ext_vector_type(8)));
typedef float f32x4 __attribute__((ext_vector_type(4)));
typedef unsigned u32x4 __attribute__((ext_vector_type(4)));
constexpr int BM = 256, BK = 64, HALF = 128, HTB = HALF * BK * 2  , STAGE_BYTES = 8 * HTB, NXCD = 8, WGM = 8;

__host__ __device__ __forceinline__ int lds_byte(int r, int c) { const int st = (r >> 4) * 2 + (c >> 5), rr = r & 15, cc = c & 31, ob = rr * 64 + cc * 2; return st * 1024 + (ob ^ (((ob >> 9) & 1) << 5)); }
__host__ __device__ __forceinline__ void stage_rc(int b, int& R, int& C) { const int st = b / 1024, sb = b % 1024, swz = sb ^ (((sb >> 9) & 1) << 5); R = (st >> 1) * 16 + swz / 64; C = (st & 1) * 32 + (swz % 64) / 2; }
__host__ __device__ __forceinline__ int perm32(int rho) { const int n = rho >> 4, i = rho & 15; return 8 * (i >> 2) + 4 * n + (i & 3); }

struct Unit { int pm, pn; };
struct Gemm { const bf16_t* A; const bf16_t* Bt; int M, N, K; };

struct StaticOrder {
    int nM, nN, nwg, G, c;
    __host__ __device__ void init(int M, int N, int G_, int c_) { nM = M / BM; nN = N / BM; nwg = nM * nN; G = G_; c = c_; }
    __host__ __device__ bool next(int i, Unit& u) const {
        const long L = (long)i * G + c; if (L >= nwg) return false;
        int wgid = (int)L; { const int q = nwg / NXCD, r = nwg % NXCD, xcd = wgid % NXCD, off = wgid / NXCD; wgid = (xcd < r ? xcd * (q + 1) : r * (q + 1) + (xcd - r) * q) + off; }
        const int nig = WGM * nN, gid = wgid / nig, fm = gid * WGM, gsz = (nM - fm) < WGM ? (nM - fm) : WGM;
        u.pm = fm + ((wgid % nig) % gsz); u.pn = (wgid % nig) / gsz; return true;
    }
    __device__ __forceinline__ void a_ready(const Unit&) const {}
    __device__ __forceinline__ void done(const Unit&) const {}
};

__device__ __forceinline__ unsigned cvt_pk_bf16(float lo, float hi) { unsigned r; asm volatile("v_cvt_pk_bf16_f32 %0, %1, %2" : "=v"(r) : "v"(lo), "v"(hi)); return r; }
typedef unsigned u32x4e __attribute__((ext_vector_type(4)));
constexpr float RMS_EPS = 1e-6f;
__device__ __forceinline__ float shx(float v, int lane, int m) { return __builtin_bit_cast(float, __builtin_amdgcn_ds_bpermute((lane ^ m) << 2, __builtin_bit_cast(int, v))); }
__device__ __forceinline__ float row_rstd(const float* part, int row) {
    const f32x4* p = (const f32x4*)(part + (size_t)row * 16);
    const f32x4 a = p[0], b = p[1], c = p[2], d = p[3];
    const float s = ((a[0] + a[1]) + (a[2] + a[3])) + ((b[0] + b[1]) + (b[2] + b[3])) + ((c[0] + c[1]) + (c[2] + c[3])) + ((d[0] + d[1]) + (d[2] + d[3]));
    return __builtin_amdgcn_rsqf(s * (1.0f / 1024.0f) + RMS_EPS);
}
__device__ __forceinline__ float silu_mul(float g, float u) { return g * u * __builtin_amdgcn_rcpf(1.0f + __builtin_amdgcn_exp2f(-1.4426950408889634f * g)); }

struct RstdTab { const PG8_LAS float* tab; int p0, p1, p2, p3;
    __device__ __forceinline__ const PG8_LAS float* rows(int pm) const { const int slot = pm == p0 ? 0 : pm == p1 ? 1 : pm == p2 ? 2 : 3; return tab + slot * 256; } };
struct EpiAct {
    static constexpr bool PERM = true, AFTER_DRAIN = false;
    bf16_t* O; int ldo; RstdTab rt;
    __device__ __forceinline__ void operator()(const f32x4 (&acc)[2][2][4][2], const Unit& u, int wr, int wc, int fr, int fq) const {
        const int row0 = u.pm * BM + wr * 64 + fr, col0 = u.pn * HALF + wc * 32 + 8 * fq;
        float rsv[8]; { const PG8_LAS float* t_ = rt.rows(u.pm) + wr * 64 + fr;
#pragma unroll
            for (int it = 0; it < 8; ++it) rsv[it] = t_[(it >> 2) * HALF + (it & 3) * 16]; }
#pragma unroll
        for (int ai = 0; ai < 2; ++ai)
#pragma unroll
            for (int m = 0; m < 4; ++m) {
                const int row = row0 + ai * HALF + m * 16; const float rs = rsv[ai * 4 + m];
                const f32x4 g0 = acc[ai][0][m][0] * rs, g1 = acc[ai][0][m][1] * rs, u0 = acc[ai][1][m][0] * rs, u1 = acc[ai][1][m][1] * rs;
                u32x4e w;
                w.x = cvt_pk_bf16(silu_mul(g0[0], u0[0]), silu_mul(g0[1], u0[1])); w.y = cvt_pk_bf16(silu_mul(g0[2], u0[2]), silu_mul(g0[3], u0[3]));
                w.z = cvt_pk_bf16(silu_mul(g1[0], u1[0]), silu_mul(g1[1], u1[1])); w.w = cvt_pk_bf16(silu_mul(g1[2], u1[2]), silu_mul(g1[3], u1[3]));
                *(u32x4e*)(O + (size_t)row * ldo + col0) = w;
            }
    }
};
struct EpiStore {
    static constexpr bool PERM = true, AFTER_DRAIN = false;
    bf16_t* O; int ldo; RstdTab rt; int qcols; float qscale;
    __device__ __forceinline__ void operator()(const f32x4 (&acc)[2][2][4][2], const Unit& u, int wr, int wc, int fr, int fq) const {
        const int row0 = u.pm * BM + wr * 64 + fr, col0 = u.pn * BM + wc * 32 + 8 * fq;
        const float cs = (u.pn * BM < qcols) ? qscale : 1.0f;
        float rsv[8]; { const PG8_LAS float* t_ = rt.rows(u.pm) + wr * 64 + fr;
#pragma unroll
            for (int it = 0; it < 8; ++it) rsv[it] = t_[(it >> 2) * HALF + (it & 3) * 16] * cs; }
#pragma unroll
        for (int ai = 0; ai < 2; ++ai)
#pragma unroll
            for (int m = 0; m < 4; ++m) {
                const int row = row0 + ai * HALF + m * 16; const float rs = rsv[ai * 4 + m];
#pragma unroll
                for (int bj = 0; bj < 2; ++bj) {
                    const f32x4 v0 = acc[ai][bj][m][0] * rs, v1 = acc[ai][bj][m][1] * rs; u32x4e w;
                    w.x = cvt_pk_bf16(v0[0], v0[1]); w.y = cvt_pk_bf16(v0[2], v0[3]); w.z = cvt_pk_bf16(v1[0], v1[1]); w.w = cvt_pk_bf16(v1[2], v1[3]);
                    { const int col = col0 + bj * HALF; *(u32x4e*)(O + ((size_t)((row >> 12) * (ldo >> 6) + (col >> 6)) * 4096 + (row & 4095)) * 64 + (col & 63)) = w; }
                }
            }
    }
};
__device__ __forceinline__ float bfl(unsigned w) { return __builtin_bit_cast(float, w << 16); }
__device__ __forceinline__ float bfh(unsigned w) { return __builtin_bit_cast(float, w & 0xffff0000u); }
typedef unsigned u32x2e __attribute__((ext_vector_type(2)));
typedef float f32x2e __attribute__((ext_vector_type(2)));
__device__ __forceinline__ unsigned lo8_pack(float a, float b, float c, float d) { int w = __builtin_amdgcn_cvt_pk_fp8_f32(a, b, 0, false); w = __builtin_amdgcn_cvt_pk_fp8_f32(c, d, w, true); return (unsigned)w; }
struct EpiRes {
    static constexpr bool PERM = true, AFTER_DRAIN = false;
    bf16_t* XH; unsigned char* XL; float* part; float* OUT; float alpha;
    __device__ __forceinline__ void operator()(const f32x4 (&acc)[2][2][4][2], const Unit& u, int wr, int wc, int fr, int fq) const {
        const int row0 = u.pm * BM + wr * 64 + fr, col0 = u.pn * BM + wc * 32 + 8 * fq;
        bf16_t* const xh_ = XH; unsigned char* const xl_ = XL; float* const part_ = part; const float alpha_ = alpha; float* const out_ = OUT;
        constexpr int ER_DEPTH = 4;
        float ssv[8];
        u32x4e hb[ER_DEPTH][2]; u32x2e lb[ER_DEPTH][2];
#define ER_LOAD(it_, buf_) do { const size_t o_ = (size_t)(row0 + ((it_) >> 2) * HALF + ((it_) & 3) * 16) * 1024 + col0; \
            hb[buf_][0] = *(const u32x4e*)(xh_ + o_); lb[buf_][0] = *(const u32x2e*)(xl_ + o_); hb[buf_][1] = *(const u32x4e*)(xh_ + o_ + HALF); lb[buf_][1] = *(const u32x2e*)(xl_ + o_ + HALF); } while (0)
#pragma unroll
        for (int it = 0; it < ER_DEPTH - 1; ++it) ER_LOAD(it, it);
#pragma unroll
        for (int it = 0; it < 8; ++it) {
            const int cur = it % ER_DEPTH, ai = it >> 2, m = it & 3;
            if (it + ER_DEPTH - 1 < 8) ER_LOAD(it + ER_DEPTH - 1, (it + ER_DEPTH - 1) % ER_DEPTH);
            asm volatile("" ::: "memory");
            const int row = row0 + ai * HALF + m * 16; float ss = 0.f;
#pragma unroll
            for (int bj = 0; bj < 2; ++bj) {
                const u32x4e hw = hb[cur][bj]; const u32x2e lw = lb[cur][bj];
                const f32x2e l0 = __builtin_amdgcn_cvt_pk_f32_fp8((int)lw.x, false), l1 = __builtin_amdgcn_cvt_pk_f32_fp8((int)lw.x, true), l2 = __builtin_amdgcn_cvt_pk_f32_fp8((int)lw.y, false), l3 = __builtin_amdgcn_cvt_pk_f32_fp8((int)lw.y, true);
                constexpr float IS = 1.0f / 256.0f;
                f32x4 x0 = {fmaf(l0[0], IS, bfl(hw.x)), fmaf(l0[1], IS, bfh(hw.x)), fmaf(l1[0], IS, bfl(hw.y)), fmaf(l1[1], IS, bfh(hw.y))};
                f32x4 x1 = {fmaf(l2[0], IS, bfl(hw.z)), fmaf(l2[1], IS, bfh(hw.z)), fmaf(l3[0], IS, bfl(hw.w)), fmaf(l3[1], IS, bfh(hw.w))};
                x0 += acc[ai][bj][m][0] * alpha_; x1 += acc[ai][bj][m][1] * alpha_;
                const size_t o = (size_t)row * 1024 + col0 + bj * HALF;
                if (out_) { *(f32x4*)(out_ + o) = x0; *(f32x4*)(out_ + o + 4) = x1; }
                else {
                    ss += (x0[0] * x0[0] + x0[1] * x0[1]) + (x0[2] * x0[2] + x0[3] * x0[3]) + (x1[0] * x1[0] + x1[1] * x1[1]) + (x1[2] * x1[2] + x1[3] * x1[3]);
                    u32x4e w; w.x = cvt_pk_bf16(x0[0], x0[1]); w.y = cvt_pk_bf16(x0[2], x0[3]); w.z = cvt_pk_bf16(x1[0], x1[1]); w.w = cvt_pk_bf16(x1[2], x1[3]);
                    u32x2e v; v.x = lo8_pack((x0[0] - bfl(w.x)) * 256.0f, (x0[1] - bfh(w.x)) * 256.0f, (x0[2] - bfl(w.y)) * 256.0f, (x0[3] - bfh(w.y)) * 256.0f);
                    v.y = lo8_pack((x1[0] - bfl(w.z)) * 256.0f, (x1[1] - bfh(w.z)) * 256.0f, (x1[2] - bfl(w.w)) * 256.0f, (x1[3] - bfh(w.w)) * 256.0f);
                    *(u32x4e*)(xh_ + o) = w; *(u32x2e*)(xl_ + o) = v;
                }
            }
            ssv[it] = ss;
        }
#undef ER_LOAD
        if (!out_) {
            const int ln = fr + 16 * fq;
#pragma unroll
            for (int it = 0; it < 8; ++it) ssv[it] += shx(ssv[it], ln, 16);
#pragma unroll
            for (int it = 0; it < 8; ++it) ssv[it] += shx(ssv[it], ln, 32);
            if (fq == 0) {
#pragma unroll
                for (int it = 0; it < 8; ++it) part_[(size_t)(row0 + (it >> 2) * HALF + (it & 3) * 16) * 16 + u.pn * 4 + wc] = ssv[it];
            }
        }
    }
};
template <class Epi, class Sched, bool ALIGN_EPI = false, bool SP2 = false>
__device__ __forceinline__ void gemm_phase(PG8_LAS unsigned char* lds, const Gemm g, const Sched& S, const Epi& E) {
    int tid_ = threadIdx.x; asm volatile("" : "+v"(tid_));
    const int tid = tid_, wid = __builtin_amdgcn_readfirstlane(tid >> 6), lane = tid & 63, wr = wid >> 2, wc = wid & 3, fr = lane & 15, fq = lane >> 4;
    const int K = g.K, nt = K / BK;
    unsigned voffA[2], voffB[2];
#pragma unroll
    for (int i = 0; i < 2; ++i) { int R, C; stage_rc(tid * 16 + i * 8192, R, C); const int Rb = Epi::PERM ? ((R & ~31) + perm32(R & 31)) : R;
        voffA[i] = (unsigned)(R * K + C) * 2u; voffB[i] = (unsigned)(Rb * K + C) * 2u; }
    const size_t kstep = (size_t)(BK * 2);
    const size_t hstep = (size_t)HALF * K * 2;
    const size_t tstep = 2 * hstep;
    const unsigned ldsw = (unsigned)wid * 1024u;
    const int aoff = lds_byte(wr * 64 + fr, fq * 8), boff = lds_byte(wc * 32 + fr, fq * 8);
#define PG8_SA(b, h) (((b) * 2 + (h)) * HTB)
#define PG8_SB(b, h) ((4 + (b) * 2 + (h)) * HTB)
#define PG8_STAGE(bufoff, gbase, voff) do { _Pragma("unroll") for (int _i = 0; _i < 2; ++_i) \
        __builtin_amdgcn_global_load_lds((const unsigned*)((const char*)(gbase) + (voff)[_i]), (PG8_LAS unsigned*)(lds + (bufoff) + ldsw + _i * 8192), 16, 0, 0); } while (0)
#define PG8_LDA(dst, b, h) do { _Pragma("unroll") for (int m = 0; m < 4; ++m) _Pragma("unroll") for (int k = 0; k < 2; ++k) dst[m][k] = *(const PG8_LAS bf16x8*)(lds + PG8_SA(b, h) + aoff + m * 2048 + k * 1024); } while (0)
#define PG8_LDB(dst, b, h) do { _Pragma("unroll") for (int n = 0; n < 2; ++n) _Pragma("unroll") for (int k = 0; k < 2; ++k) dst[n][k] = *(const PG8_LAS bf16x8*)(lds + PG8_SB(b, h) + boff + n * 2048 + k * 1024); } while (0)
#define PG8_MMA(ai, bj, At, Bt) do { __builtin_amdgcn_s_setprio(1); _Pragma("unroll") for (int m = 0; m < 4; ++m) _Pragma("unroll") for (int n = 0; n < 2; ++n) _Pragma("unroll") for (int k = 0; k < 2; ++k) \
        acc[ai][bj][m][n] = __builtin_amdgcn_mfma_f32_16x16x32_bf16(Bt[n][k], At[m][k], acc[ai][bj][m][n], 0, 0, 0); __builtin_amdgcn_s_setprio(0); } while (0)
#define PG8_WAIT_V(n) asm volatile("s_waitcnt vmcnt(" #n ")" ::: "memory")
#define PG8_WAIT_L(n) asm volatile("s_waitcnt lgkmcnt(" #n ")" ::: "memory")
#define PG8_BAR __builtin_amdgcn_s_barrier()
#define PG8_SCHED __builtin_amdgcn_sched_barrier(0)
    Unit cur, nxt; int ui = 0;
    if (!S.next(0, cur)) return;
    f32x4 acc[2][2][4][2];
#pragma unroll
    for (int a = 0; a < 2; ++a)
#pragma unroll
        for (int b = 0; b < 2; ++b)
#pragma unroll
            for (int m = 0; m < 4; ++m)
#pragma unroll
                for (int n = 0; n < 2; ++n) acc[a][b][m][n] = (f32x4){0.f, 0.f, 0.f, 0.f};
    bf16x8 At[4][2], B0[2][2], B1[2][2];
    const char* cA = (const char*)g.A + (size_t)cur.pm * tstep; const char* cB = (const char*)g.Bt + (size_t)cur.pn * tstep;
    S.a_ready(cur);
    if constexpr (SP2) {
        PG8_STAGE(PG8_SB(0, 0), cB, voffB); PG8_STAGE(PG8_SB(0, 1), cB + hstep, voffB); PG8_STAGE(PG8_SA(0, 0), cA, voffA); PG8_STAGE(PG8_SA(0, 1), cA + hstep, voffA);
        if (wr == 1) PG8_BAR;
        PG8_WAIT_V(2); PG8_BAR;
        PG8_STAGE(PG8_SB(1, 0), cB + kstep, voffB); PG8_STAGE(PG8_SA(1, 0), cA + kstep, voffA); PG8_STAGE(PG8_SB(1, 1), cB + hstep + kstep, voffB);
        PG8_WAIT_V(6); PG8_BAR;
    } else {
        PG8_STAGE(PG8_SB(0, 0), cB, voffB); PG8_STAGE(PG8_SA(0, 0), cA, voffA); PG8_STAGE(PG8_SB(0, 1), cB + hstep, voffB); PG8_STAGE(PG8_SA(0, 1), cA + hstep, voffA);
        if (wr == 1) PG8_BAR;
        PG8_WAIT_V(4); PG8_BAR;
        PG8_STAGE(PG8_SB(1, 0), cB + kstep, voffB); PG8_STAGE(PG8_SA(1, 0), cA + kstep, voffA); PG8_STAGE(PG8_SB(1, 1), cB + hstep + kstep, voffB);
        PG8_WAIT_V(6); PG8_BAR;
    }
    for (;;) {
        const bool has_next = S.next(ui + 1, nxt);
        const char* nA = has_next ? (const char*)g.A + (size_t)nxt.pm * tstep : cA; const char* nB = has_next ? (const char*)g.Bt + (size_t)nxt.pn * tstep : cB;
        for (int t = 0; t < nt; t += 2) {
            const bool last = (t == nt - 2);
            const char* a1 = cA + (size_t)(t + 1) * kstep;
            const char* a2 = last ? nA : cA + (size_t)(t + 2) * kstep; const char* b2 = last ? nB : cB + (size_t)(t + 2) * kstep;
            const char* a3 = a2 + kstep; const char* b3 = b2 + kstep;
            if (last && has_next) S.a_ready(nxt);
            if constexpr (SP2) {
            PG8_LDB(B0, 0, 0); PG8_LDB(B1, 0, 1); PG8_SCHED; PG8_LDA(At, 0, 0); PG8_STAGE(PG8_SA(1, 1), a1 + hstep, voffA);
            PG8_WAIT_V(8); PG8_WAIT_L(0); PG8_BAR; PG8_MMA(0, 0, At, B0); PG8_MMA(0, 1, At, B1); PG8_BAR; PG8_SCHED;
            PG8_LDA(At, 0, 1); PG8_STAGE(PG8_SB(0, 0), b2, voffB); PG8_STAGE(PG8_SB(0, 1), b2 + hstep, voffB); PG8_STAGE(PG8_SA(0, 0), a2, voffA);
            PG8_WAIT_V(8); PG8_WAIT_L(0); PG8_BAR; PG8_MMA(1, 0, At, B0); PG8_MMA(1, 1, At, B1); PG8_BAR; PG8_SCHED;
            PG8_LDB(B0, 1, 0); PG8_LDB(B1, 1, 1); PG8_SCHED; PG8_LDA(At, 1, 0); PG8_STAGE(PG8_SA(0, 1), a2 + hstep, voffA);
            PG8_WAIT_V(8); PG8_WAIT_L(0); PG8_BAR; PG8_MMA(0, 0, At, B0); PG8_MMA(0, 1, At, B1); PG8_BAR; PG8_SCHED;
            PG8_LDA(At, 1, 1); PG8_STAGE(PG8_SB(1, 0), b3, voffB); PG8_STAGE(PG8_SB(1, 1), b3 + hstep, voffB); PG8_STAGE(PG8_SA(1, 0), a3, voffA);
            PG8_WAIT_V(8); PG8_WAIT_L(0); PG8_BAR; PG8_MMA(1, 0, At, B0); PG8_MMA(1, 1, At, B1); PG8_BAR; PG8_SCHED;
            } else {
            PG8_LDB(B0, 0, 0); PG8_SCHED; PG8_LDA(At, 0, 0); PG8_STAGE(PG8_SA(1, 1), a1 + hstep, voffA);
            PG8_WAIT_L(8); PG8_BAR; PG8_WAIT_L(0); PG8_MMA(0, 0, At, B0); PG8_BAR; PG8_SCHED;
            PG8_LDB(B1, 0, 1); PG8_STAGE(PG8_SB(0, 0), b2, voffB);
            PG8_BAR; PG8_WAIT_L(0); PG8_MMA(0, 1, At, B1); PG8_BAR;
            PG8_LDA(At, 0, 1); PG8_STAGE(PG8_SA(0, 0), a2, voffA);
            PG8_BAR; PG8_WAIT_L(0); PG8_MMA(1, 0, At, B0); PG8_BAR; PG8_SCHED;
            PG8_STAGE(PG8_SB(0, 1), b2 + hstep, voffB);
            PG8_WAIT_V(6); PG8_BAR; PG8_MMA(1, 1, At, B1); PG8_BAR;
            PG8_LDB(B0, 1, 0); PG8_SCHED; PG8_LDA(At, 1, 0); PG8_STAGE(PG8_SA(0, 1), a2 + hstep, voffA);
            PG8_WAIT_L(8); PG8_BAR; PG8_WAIT_L(0); PG8_MMA(0, 0, At, B0); PG8_BAR; PG8_SCHED;
            PG8_LDB(B1, 1, 1); PG8_STAGE(PG8_SB(1, 0), b3, voffB);
            PG8_BAR; PG8_WAIT_L(0); PG8_MMA(0, 1, At, B1); PG8_BAR;
            PG8_LDA(At, 1, 1); PG8_STAGE(PG8_SA(1, 0), a3, voffA);
            PG8_BAR; PG8_WAIT_L(0); PG8_MMA(1, 0, At, B0); PG8_BAR; PG8_SCHED;
            PG8_STAGE(PG8_SB(1, 1), b3 + hstep, voffB);
            PG8_WAIT_V(6); PG8_BAR; PG8_MMA(1, 1, At, B1); PG8_BAR;
            }
        }
        if constexpr (ALIGN_EPI) { if (wr == 0) PG8_BAR; }
        if constexpr (!Epi::AFTER_DRAIN) { E(acc, cur, wr, wc, fr, fq); S.done(cur); }
        if (!has_next) break;
#pragma unroll
        for (int a = 0; a < 2; ++a)
#pragma unroll
            for (int b = 0; b < 2; ++b)
#pragma unroll
                for (int m = 0; m < 4; ++m)
#pragma unroll
                    for (int n = 0; n < 2; ++n) acc[a][b][m][n] = (f32x4){0.f, 0.f, 0.f, 0.f};
        cur = nxt; cA = nA; cB = nB; ++ui;
        if constexpr (ALIGN_EPI) { if (wr == 1) PG8_BAR; }
    }
    PG8_WAIT_V(0);
    if constexpr (!ALIGN_EPI) { if (wr == 0) PG8_BAR; }
    PG8_BAR;
    if constexpr (Epi::AFTER_DRAIN) { E.fused(acc, cur, wr, wc, fr, fq, lds, wid, lane); S.done(cur); }
#undef PG8_SA
#undef PG8_SB
#undef PG8_STAGE
#undef PG8_LDA
#undef PG8_LDB
#undef PG8_MMA
#undef PG8_WAIT_V
#undef PG8_WAIT_L
#undef PG8_BAR
#undef PG8_SCHED
}
}

#define LAS __attribute__((address_space(3)))
typedef unsigned short bf16;
typedef unsigned v4u __attribute__((ext_vector_type(4)));
typedef float f32x4 __attribute__((ext_vector_type(4)));
constexpr int NWAVES = 8, NTHR = 512;
constexpr int BATCH = 8, SEQ = 4096, D = 1024, M = BATCH * SEQ, FF = 2816, NGU = 2 * FF, DEPTH = 4;
constexpr int SBN = 3072, SWN = 1280, HD = 64;
constexpr size_t MiB = 1u << 20;
constexpr size_t WS_WGU = 0;
constexpr size_t WS_WD = WS_WGU + 88 * MiB;
constexpr size_t WS_SBIN = WS_WD + 44 * MiB;
constexpr size_t WS_SBOUT = WS_SBIN + 12 * MiB;
constexpr size_t WS_SWIN = WS_SBOUT + 4 * MiB;
constexpr size_t WS_SWOUT = WS_SWIN + 5 * MiB;
constexpr size_t WS_XB = WS_SWOUT + 4 * MiB;
constexpr size_t WS_XL = WS_XB + 64 * MiB;
constexpr size_t WS_PART = WS_XL + 64 * MiB;
constexpr size_t WS_ROPE = WS_PART + 2 * MiB;
constexpr size_t WS_SMALL = WS_ROPE + 2 * MiB;
constexpr size_t WS_ACT = WS_SMALL + 1 * MiB;
constexpr size_t WS_QKV = WS_ACT;
constexpr size_t WS_O = WS_QKV + 192 * MiB;
constexpr size_t WS_CTL = WS_O + 64 * MiB;
constexpr size_t CTL_ZERO_BYTES = 16384;
constexpr size_t WS_END = WS_CTL + 1 * MiB;
constexpr int MISC_OFF = 147456 - 256;
constexpr int LDS_BYTES = 147456;

__device__ __forceinline__ unsigned f2bf(float f) { unsigned u = __builtin_bit_cast(unsigned, f); return (u + 0x7fffu + ((u >> 16) & 1u)) >> 16; }
__device__ __forceinline__ unsigned pk2(float lo, float hi) { return f2bf(lo) | (f2bf(hi) << 16); }
__device__ __forceinline__ float bf_lo(unsigned w) { return __uint_as_float(w << 16); }
__device__ __forceinline__ float bf_hi(unsigned w) { return __uint_as_float(w & 0xffff0000u); }
#define LDS_WAIT() asm volatile("s_waitcnt lgkmcnt(0)" ::: "memory")
__device__ __forceinline__ float wave_sum(float v) {
#pragma unroll
    for (int o = 1; o < 64; o <<= 1) v += __shfl_xor(v, o);
    return v;
}

struct Args {
    const float* x; const int* pos; const float* gains; const float* wgu; const float* wd; const float* sbin; const float* sbout;
    const float* swin; const float* swout; const float* qg; const float* kg; const float* sinks;
    float* out; unsigned char* ws; int ph_lo, ph_hi;
};

__device__ __forceinline__ void transpose_item(const float* W, int K, int N, bf16* WT, int out_row, const float* gain, LAS float* scr, int k0, int n0, int lane) {
    const int r4 = lane >> 4, c4 = (lane & 15) * 4;
    f32x4 wv[16];
#pragma unroll
    for (int i = 0; i < 16; ++i) wv[i] = *(const f32x4*)(W + (size_t)(k0 + 4 * i + r4) * N + n0 + c4);
#pragma unroll
    for (int i = 0; i < 16; ++i) { const int kk = 4 * i + r4; f32x4 v = wv[i]; if (gain) v *= gain[k0 + kk];
        LAS float* d = scr + kk * 65 + c4; d[0] = v[0]; d[1] = v[1]; d[2] = v[2]; d[3] = v[3]; }
    LDS_WAIT(); asm volatile("" ::: "memory");
    const int c = lane & 7;
#pragma unroll
    for (int j = 0; j < 8; ++j) { const int n = (lane >> 3) + 8 * j; const LAS float* s = scr + (8 * c) * 65 + n;
        v4u o; o.x = pk2(s[0 * 65], s[1 * 65]); o.y = pk2(s[2 * 65], s[3 * 65]); o.z = pk2(s[4 * 65], s[5 * 65]); o.w = pk2(s[6 * 65], s[7 * 65]);
        *(v4u*)(WT + (size_t)(out_row + n) * K + k0 + 8 * c) = o; }
    LDS_WAIT(); asm volatile("" ::: "memory");
}
constexpr int IT_GU = (D / 64) * (NGU / 64), IT_DN = (FF / 64) * (D / 64), IT_SBI = (D / 64) * (SBN / 64), IT_SQ = (D / 64) * (D / 64), IT_SWI = (D / 64) * (SWN / 64);
constexpr int IT_END_GU = 8 * IT_GU, IT_END_DN = IT_END_GU + 8 * IT_DN, IT_END_SBI = IT_END_DN + 2 * IT_SBI, IT_END_SBO = IT_END_SBI + 2 * IT_SQ, IT_END_SWI = IT_END_SBO + 2 * IT_SWI, IT_END = IT_END_SWI + 2 * IT_SQ;
__device__ __forceinline__ void prologue(const Args& a, LAS unsigned char* lds, int wave, int lane) {
    LAS float* scr = (LAS float*)(lds + wave * 16640);
    const int gw = blockIdx.x * NWAVES + wave, NGW = gridDim.x * NWAVES;
    unsigned char* ws = a.ws;
    for (int itf = gw; itf < IT_END; itf += NGW) {
        const int it = IT_END - 1 - itf;
        const float* W; bf16* WT; const float* gain = nullptr; int K = D, N, mode = 0, r;
        if (it < IT_END_GU) { const int mi = it / IT_GU; r = it % IT_GU; W = a.wgu + (size_t)mi * D * NGU; WT = (bf16*)(ws + WS_WGU) + (size_t)mi * NGU * D; N = NGU; mode = 1; gain = a.gains + (size_t)((mi >> 1) * 3 + 2 * (mi & 1)) * D; }
        else if (it < IT_END_DN) { const int q = it - IT_END_GU, mi = q / IT_DN; r = q % IT_DN; W = a.wd + (size_t)mi * FF * D; WT = (bf16*)(ws + WS_WD) + (size_t)mi * D * FF; K = FF; N = D; }
        else if (it < IT_END_SBI) { const int q = it - IT_END_DN, s = q / IT_SBI; r = q % IT_SBI; W = a.sbin + (size_t)s * D * SBN; WT = (bf16*)(ws + WS_SBIN) + (size_t)s * SBN * D; N = SBN; gain = a.gains + (size_t)((2 * s) * 3 + 1) * D; }
        else if (it < IT_END_SBO) { const int q = it - IT_END_SBI, s = q / IT_SQ; r = q % IT_SQ; W = a.sbout + (size_t)s * D * D; WT = (bf16*)(ws + WS_SBOUT) + (size_t)s * D * D; N = D; }
        else if (it < IT_END_SWI) { const int q = it - IT_END_SBO, s = q / IT_SWI; r = q % IT_SWI; W = a.swin + (size_t)s * D * SWN; WT = (bf16*)(ws + WS_SWIN) + (size_t)s * SWN * D; N = SWN; gain = a.gains + (size_t)((2 * s + 1) * 3 + 1) * D; }
        else { const int q = it - IT_END_SWI, s = q / IT_SQ; r = q % IT_SQ; W = a.swout + (size_t)s * D * D; WT = (bf16*)(ws + WS_SWOUT) + (size_t)s * D * D; N = D; }
        const int nblk = N / 64, kb = r / nblk, nb = r % nblk, n0 = 64 * nb;
        int orow = n0;
        if (mode == 1) { const int j = n0 < FF ? n0 : n0 - FF; orow = (j / 128) * 256 + (n0 < FF ? 0 : 128) + (j % 128); }
        transpose_item(W, K, N, WT, orow, gain, scr, 64 * kb, n0, lane);
    }
    if (blockIdx.x == 0 && wave == 0) { float* sm = (float*)(ws + WS_SMALL); sm[lane] = a.qg[lane]; sm[64 + lane] = a.qg[64 + lane]; sm[128 + lane] = a.kg[lane]; sm[192 + lane] = a.kg[64 + lane]; if (lane < 32) sm[256 + lane] = a.sinks[lane]; }
    bf16* XB = (bf16*)(ws + WS_XB); unsigned char* XL = ws + WS_XL; float* part = (float*)(ws + WS_PART); float* rope = (float*)(ws + WS_ROPE);
    f32x4 xc[4], xn[4];
    if (gw < M) {
#pragma unroll
        for (int j = 0; j < 4; ++j) xc[j] = ((const f32x4*)(a.x + (size_t)gw * D) + lane)[64 * j]; }
    for (int m = gw; m < M; m += NGW) {
        if (m + NGW < M) {
#pragma unroll
            for (int j = 0; j < 4; ++j) xn[j] = ((const f32x4*)(a.x + (size_t)(m + NGW) * D) + lane)[64 * j]; }
        unsigned long long* b8 = (unsigned long long*)(XB + (size_t)m * D) + lane; unsigned* l8 = (unsigned*)(XL + (size_t)m * D) + lane;
        float s = 0.f;
#pragma unroll
        for (int j = 0; j < 4; ++j) { const f32x4 v = xc[j]; s += (v[0] * v[0] + v[1] * v[1]) + (v[2] * v[2] + v[3] * v[3]);
            const unsigned h0 = pk2(v[0], v[1]), h1 = pk2(v[2], v[3]);
            b8[64 * j] = (unsigned long long)h0 | ((unsigned long long)h1 << 32);
            l8[64 * j] = pg8::lo8_pack((v[0] - bf_lo(h0)) * 256.0f, (v[1] - bf_hi(h0)) * 256.0f, (v[2] - bf_lo(h1)) * 256.0f, (v[3] - bf_hi(h1)) * 256.0f); }
        s = wave_sum(s);
        if (lane < 16) part[(size_t)m * 16 + lane] = lane == 0 ? s : 0.f;
        if (lane < 8) {
            const float invf[8] = {1.0f, 0.1939227432012558f, 0.03760603070259094f, 0.007292664609849453f, 0.0014142135623842478f, 0.00027424818836152554f, 5.318296098266728e-05f, 1.0313386155758053e-05f};
            float fr = invf[0];
#pragma unroll
            for (int i = 1; i < 8; ++i) fr = lane == i ? invf[i] : fr;
            const float ang = (float)a.pos[m] * fr;
            const float k = rintf(ang * 0.15915494309189535f);
            float r = fmaf(-k, 6.2831855f, ang); r = fmaf(-k, -1.7484555e-7f, r);
            const float rev = r * 0.15915494309189535f;
            rope[(size_t)m * 16 + lane] = __builtin_amdgcn_cosf(rev); rope[(size_t)m * 16 + 8 + lane] = __builtin_amdgcn_sinf(rev);
        }
#pragma unroll
        for (int j = 0; j < 4; ++j) xc[j] = xn[j];
    }
}


namespace sbat {
typedef short bf16x8 __attribute__((ext_vector_type(8)));
typedef short s16x4 __attribute__((ext_vector_type(4)));
typedef float f32x16 __attribute__((ext_vector_type(16)));
typedef float f32x2_t __attribute__((ext_vector_type(2)));
typedef __bf16 bf16x2_t __attribute__((ext_vector_type(2)));
typedef unsigned u32x2 __attribute__((ext_vector_type(2)));
__device__ __forceinline__ unsigned cvtpk(float lo, float hi) { f32x2_t v = {lo, hi}; bf16x2_t b = __builtin_convertvector(v, bf16x2_t); return __builtin_bit_cast(unsigned, b); }
constexpr int KROW = 144, VROW = 144, KT_BYTES = 64 * KROW, VT_BYTES = 64 * VROW, BUF_BYTES = KT_BYTES + VT_BYTES;
#define SB_MFMA(a, b, c) __builtin_amdgcn_mfma_f32_32x32x16_bf16((a), (b), (c), 0, 0, 0)
template <bool MASKED>
__device__ __forceinline__ void local_scan(const f32x16& S, float (&d)[16], float& T, int kpos0, int qpos) {
    float kp[16];
#pragma unroll
    for (int r = 0; r < 16; ++r) {
        const float e = __builtin_amdgcn_exp2f(S[r]);
        float k = __builtin_amdgcn_rcpf(1.0f + e);
        if (MASKED) k = (kpos0 + r < qpos) ? k : 1.0f;
        kp[r] = k;
    }
    float c = 1.0f;
#pragma unroll
    for (int r = 15; r >= 0; --r) { const float cn = c * kp[r]; d[r] = c - cn; c = cn; }
    T = c;
}
constexpr int WV_ROW = 80, WV_BUF = 64 * WV_ROW, WK_ROW = 144, WK_BUF = 32 * WK_ROW, WV_BYTES = WV_BUF + WK_BUF;
__device__ __forceinline__ void sb_attn(const bf16* QKV, bf16* O, LAS unsigned char* lds, int tid) {
    const int lane = tid & 63, wave = __builtin_amdgcn_readfirstlane(tid >> 6), l32 = lane & 31, hi = lane >> 5;
    const int vdc = lane & 7, vkg = lane >> 3;
    LAS unsigned char* vimg = lds + wave * WV_BYTES; LAS unsigned char* kimg = vimg + WV_BUF;
    const int gw = blockIdx.x * NWAVES + wave, NGW = gridDim.x * NWAVES;
    for (int u = gw; u < BATCH * 16 * (SEQ / 32); u += NGW) {
        const int qblk = u & 127, bh = u >> 7, b = bh >> 4, h = bh & 15;
        const size_t tok0 = (size_t)b * SEQ;
        const int qr0 = qblk * 32, qpos = qr0 + l32;
        bf16x8 qf[4], kn[4]; v4u vreg[4];
        const bf16* const Qh = QKV + (size_t)(b * 48 + h) * SEQ * 64; const bf16* const Kh = QKV + (size_t)(b * 48 + 16 + h) * SEQ * 64; const bf16* const Vh = QKV + (size_t)(b * 48 + 32 + h) * SEQ * 64;
        { const bf16* qp = Qh + (size_t)(qr0 + l32) * 64 + 8 * hi;
#pragma unroll
          for (int ks = 0; ks < 4; ++ks) qf[ks] = *(const bf16x8*)(qp + 16 * ks); }
#define SBW_LOAD(sb_) do { const bf16* kp_ = Kh + (size_t)(32 * (sb_) + vkg) * 64 + 8 * vdc; \
            _Pragma("unroll") for (int j_ = 0; j_ < 4; ++j_) kn[j_] = *(const bf16x8*)(kp_ + (size_t)(8 * j_) * 64); \
            _Pragma("unroll") for (int i_ = 0; i_ < 4; ++i_) vreg[i_] = *(const v4u*)(Vh + (size_t)(32 * (sb_) + 4 * vkg + i_) * 64 + 8 * vdc); } while (0)
        SBW_LOAD(qblk);
        f32x16 o0, o1;
#pragma unroll
        for (int r = 0; r < 16; ++r) { o0[r] = 0.f; o1[r] = 0.f; }
        float carry = 1.0f;
        int p = 0;
        for (int sb = qblk; sb >= 0; --sb) {
            LAS unsigned char* vb = vimg;
#pragma unroll
            for (int j = 0; j < 4; ++j) *(LAS bf16x8*)(kimg + (8 * (2 * (j & 1) + (vkg >> 2)) + 4 * (j >> 1) + (vkg & 3)) * WK_ROW + 16 * vdc) = kn[j];
#pragma unroll
            for (int j = 0; j < 4; ++j) {
                const unsigned w0 = vreg[0][j], w1 = vreg[1][j], w2 = vreg[2][j], w3 = vreg[3][j];
                const u32x2 e = {(w0 & 0xffffu) | (w1 << 16), (w2 & 0xffffu) | (w3 << 16)};
                const u32x2 o = {(w0 >> 16) | (w1 & 0xffff0000u), (w2 >> 16) | (w3 & 0xffff0000u)};
                *(LAS u32x2*)(vb + (8 * vdc + 2 * j) * WV_ROW + 8 * vkg) = e; *(LAS u32x2*)(vb + (8 * vdc + 2 * j + 1) * WV_ROW + 8 * vkg) = o;
            }
            if (sb > 0) SBW_LOAD(sb - 1);
            f32x16 S;
#pragma unroll
            for (int r = 0; r < 16; ++r) S[r] = 0.f;
#pragma unroll
            for (int ks = 0; ks < 4; ++ks) { const bf16x8 kc = *(const LAS bf16x8*)(kimg + l32 * WK_ROW + 32 * ks + 16 * hi); S = SB_MFMA(kc, qf[ks], S); }
            float d[16], T;
            if (sb == qblk) local_scan<true>(S, d, T, 32 * sb + 16 * hi, qpos); else local_scan<false>(S, d, T, 0, 0);
            unsigned tb = __builtin_bit_cast(unsigned, T);
            asm volatile("" : "+v"(tb));
            const auto sw = __builtin_amdgcn_permlane32_swap(__builtin_bit_cast(unsigned, T), tb, false, false);
            const unsigned ulo = sw[0], uhi = sw[1];
            const float tlo = __builtin_bit_cast(float, ulo), thi = __builtin_bit_cast(float, uhi);
            const float R = hi ? carry : carry * thi;
            carry = carry * (tlo * thi);
            unsigned pw[8];
#pragma unroll
            for (int i = 0; i < 8; ++i) pw[i] = cvtpk(d[2 * i] * R, d[2 * i + 1] * R);
            __builtin_amdgcn_wave_barrier();
#pragma unroll
            for (int kk = 0; kk < 2; ++kk) {
                const v4u pv = {pw[4 * kk], pw[4 * kk + 1], pw[4 * kk + 2], pw[4 * kk + 3]};
                const bf16x8 pb = __builtin_bit_cast(bf16x8, pv);
                const bf16x8 a0 = *(const LAS bf16x8*)(vb + l32 * WV_ROW + (16 * hi + 8 * kk) * 2), a1 = *(const LAS bf16x8*)(vb + (32 + l32) * WV_ROW + (16 * hi + 8 * kk) * 2);
                o0 = SB_MFMA(a0, pb, o0); o1 = SB_MFMA(a1, pb, o1);
            }
            p ^= 1;
            if (__builtin_amdgcn_ballot_w64(carry >= 9.094947017729282e-13f) == 0ull) break;
        }
#undef SBW_LOAD
        { bf16* op = O + (tok0 + qr0 + l32) * D + h * 64 + 4 * hi;
#pragma unroll
          for (int g = 0; g < 4; ++g) {
              const u32x2 a = {cvtpk(o0[4 * g], o0[4 * g + 1]), cvtpk(o0[4 * g + 2], o0[4 * g + 3])}, c = {cvtpk(o1[4 * g], o1[4 * g + 1]), cvtpk(o1[4 * g + 2], o1[4 * g + 3])};
              *(u32x2*)(op + 8 * g) = a; *(u32x2*)(op + 32 + 8 * g) = c; } }
    }
}
}


namespace swat {
using sbat::bf16x8; using sbat::f32x16; using sbat::u32x2; using sbat::cvtpk;
constexpr int KROW = 144, VROW = 520, K_BYTES = 256 * KROW, V_BYTES = 64 * VROW;
__device__ __forceinline__ void halves(float v, float& lo, float& up) {
    unsigned a = __builtin_bit_cast(unsigned, v), b = a; asm volatile("" : "+v"(b));
    const auto r = __builtin_amdgcn_permlane32_swap(a, b, false, false);
    const unsigned r0 = r[0], r1 = r[1];
    lo = __builtin_bit_cast(float, r0); up = __builtin_bit_cast(float, r1);
}
__device__ __forceinline__ void unpack8(const v4u w, float* v) { v[0] = bf_lo(w.x); v[1] = bf_hi(w.x); v[2] = bf_lo(w.y); v[3] = bf_hi(w.y); v[4] = bf_lo(w.z); v[5] = bf_hi(w.z); v[6] = bf_lo(w.w); v[7] = bf_hi(w.w); }
__device__ __forceinline__ void sw_attn(const bf16* QKV, const float* rope, const float* qg, const float* kg, const float* sinks, bf16* O, LAS unsigned char* lds, int tid) {
    const int lane = tid & 63, wave = __builtin_amdgcn_readfirstlane(tid >> 6), l32 = lane & 31, hi = lane >> 5;
    LAS unsigned char* kl = lds; LAS unsigned char* vl = lds + K_BYTES;
    constexpr float QS = 0.125f * 1.4426950408889634f;
    LAS float* gtab = (LAS float*)(lds + K_BYTES + V_BYTES);
    if (tid < 64) { gtab[tid] = qg[tid]; gtab[64 + tid] = kg[tid]; }
    for (int u = blockIdx.x; u < 512; u += gridDim.x) {
        const int blk = u & 31, kvh = (u >> 5) & 1, b = u >> 6;
        const size_t tok0 = (size_t)b * SEQ;
        __syncthreads();
        v4u qraw[4]; f32x4 rraw[4];
#define SW_LOADQ(p_) do { const int T_ = wave + 8 * (p_), tb_ = T_ & 3, hq_ = kvh * 8 + (T_ >> 2); const size_t qrow_ = tok0 + blk * 128 + tb_ * 32 + l32; \
            const bf16* qp_ = QKV + ((size_t)(b * 20 + hq_) * SEQ + blk * 128 + tb_ * 32 + l32) * 64 + 8 * hi; const f32x4* rp_ = (const f32x4*)(rope + qrow_ * 16); \
            _Pragma("unroll") for (int ks_ = 0; ks_ < 4; ++ks_) { qraw[ks_] = *(const v4u*)(qp_ + 16 * ks_); rraw[ks_] = rp_[ks_]; } } while (0)
        SW_LOADQ(0);
        {
            const int row = tid >> 1, half = tid & 1, kpos = blk * 128 - 128 + row;
            v4u outw[4];
            if (kpos >= 0) {
                const bf16* kp = QKV + ((size_t)(b * 20 + 16 + kvh) * SEQ + kpos) * 64 + 32 * half;
                float v[32];
#pragma unroll
                for (int c = 0; c < 4; ++c) unpack8(*(const v4u*)(kp + 8 * c), v + 8 * c);
                float ss = 0.f;
#pragma unroll
                for (int d = 0; d < 32; ++d) ss = fmaf(v[d], v[d], ss);
                ss += pg8::shx(ss, lane, 1);
                const float rs = __builtin_amdgcn_rsqf(ss * (1.0f / 64.0f) + 1e-6f);
#pragma unroll
                for (int d4 = 0; d4 < 8; ++d4) { const f32x4 g4 = *(const LAS f32x4*)(gtab + 64 + 32 * half + 4 * d4); v[4 * d4] *= rs * g4[0]; v[4 * d4 + 1] *= rs * g4[1]; v[4 * d4 + 2] *= rs * g4[2]; v[4 * d4 + 3] *= rs * g4[3]; }
                if (half == 0) { const f32x4* rp4 = (const f32x4*)(rope + (tok0 + kpos) * 16); const f32x4 c0 = rp4[0], c1 = rp4[1], s0 = rp4[2], s1 = rp4[3];
#pragma unroll
                    for (int i = 0; i < 8; ++i) { const float c = i < 4 ? c0[i & 3] : c1[i & 3], sn = i < 4 ? s0[i & 3] : s1[i & 3], x1 = v[i], x2 = v[8 + i]; v[i] = x1 * c - x2 * sn; v[8 + i] = x2 * c + x1 * sn; } }
#pragma unroll
                for (int c = 0; c < 4; ++c) outw[c] = (v4u){cvtpk(v[8 * c], v[8 * c + 1]), cvtpk(v[8 * c + 2], v[8 * c + 3]), cvtpk(v[8 * c + 4], v[8 * c + 5]), cvtpk(v[8 * c + 6], v[8 * c + 7])};
            } else {
#pragma unroll
                for (int c = 0; c < 4; ++c) outw[c] = (v4u){0u, 0u, 0u, 0u};
            }
#pragma unroll
            for (int c = 0; c < 4; ++c) *(LAS v4u*)(kl + row * KROW + 64 * half + 16 * c) = outw[c];
        }
        {
            const int vdc = tid & 7, vkg = tid >> 3, kpos0 = blk * 128 - 128 + 4 * vkg;
            v4u vreg[4];
#pragma unroll
            for (int i = 0; i < 4; ++i) vreg[i] = kpos0 >= 0 ? *(const v4u*)(QKV + ((size_t)(b * 20 + 18 + kvh) * SEQ + kpos0 + i) * 64 + 8 * vdc) : (v4u){0u, 0u, 0u, 0u};
#pragma unroll
            for (int j = 0; j < 4; ++j) {
                const unsigned w0 = vreg[0][j], w1 = vreg[1][j], w2 = vreg[2][j], w3 = vreg[3][j];
                const u32x2 e = {(w0 & 0xffffu) | (w1 << 16), (w2 & 0xffffu) | (w3 << 16)};
                const u32x2 o = {(w0 >> 16) | (w1 & 0xffff0000u), (w2 >> 16) | (w3 & 0xffff0000u)};
                *(LAS u32x2*)(vl + (8 * vdc + 2 * j) * VROW + 8 * vkg) = e; *(LAS u32x2*)(vl + (8 * vdc + 2 * j + 1) * VROW + 8 * vkg) = o;
            }
        }
        __syncthreads();
        for (int p = 0; p < 4; ++p) {
            const int T = wave + 8 * p, tb = T & 3, g = T >> 2, hq = kvh * 8 + g;
            const size_t qrow = tok0 + blk * 128 + tb * 32 + l32;
            bf16x8 qf[4];
            {
                float qv[4][8]; float ss = 0.f;
#pragma unroll
                for (int ks = 0; ks < 4; ++ks) { unpack8(qraw[ks], qv[ks]);
#pragma unroll
                    for (int i = 0; i < 8; ++i) ss = fmaf(qv[ks][i], qv[ks][i], ss); }
                { float lo_, up_; halves(ss, lo_, up_); ss = lo_ + up_; }
                const float rs = __builtin_amdgcn_rsqf(ss * (1.0f / 64.0f) + 1e-6f);
#pragma unroll
                for (int ks = 0; ks < 4; ++ks) { const f32x4 g0 = *(const LAS f32x4*)(gtab + 16 * ks + 8 * hi), g1 = *(const LAS f32x4*)(gtab + 16 * ks + 8 * hi + 4);
#pragma unroll
                    for (int i = 0; i < 8; ++i) qv[ks][i] = qv[ks][i] * rs * (i < 4 ? g0[i & 3] : g1[i & 3]); }
#pragma unroll
                for (int i = 0; i < 8; ++i) { float lo_, up_; const float own = qv[0][i]; halves(own, lo_, up_); const float oth = hi ? lo_ : up_, c = i < 4 ? rraw[0][i & 3] : rraw[1][i & 3], sn = i < 4 ? rraw[2][i & 3] : rraw[3][i & 3]; qv[0][i] = own * c + oth * (hi ? sn : -sn); }
#pragma unroll
                for (int ks = 0; ks < 4; ++ks) { const v4u w = {cvtpk(qv[ks][0] * QS, qv[ks][1] * QS), cvtpk(qv[ks][2] * QS, qv[ks][3] * QS), cvtpk(qv[ks][4] * QS, qv[ks][5] * QS), cvtpk(qv[ks][6] * QS, qv[ks][7] * QS)}; qf[ks] = __builtin_bit_cast(bf16x8, w); }
            }
            if (p < 3) SW_LOADQ(p + 1);
            const float sink = sinks[hq] * 1.4426950408889634f;
            f32x16 s[5]; float mx = sink;
            const float NEG = -__builtin_inff();
#pragma unroll
            for (int js = 0; js < 5; ++js) {
#pragma unroll
                for (int r = 0; r < 16; ++r) s[js][r] = 0.f;
                const bool live = !(blk == 0 && tb + js < 4);
                if (live) {
#pragma unroll
                    for (int ks = 0; ks < 4; ++ks) { const bf16x8 a = *(const LAS bf16x8*)(kl + (32 * (tb + js) + l32) * KROW + 32 * ks + 16 * hi); s[js] = SB_MFMA(a, qf[ks], s[js]); }
#pragma unroll
                    for (int r = 0; r < 16; ++r) {
                        const int kk = (r & 3) + 8 * (r >> 2) + 4 * hi;
                        float v = s[js][r];
                        if (js == 0) v = (kk > l32) ? v : NEG;
                        if (js == 4) v = (kk <= l32) ? v : NEG;
                        s[js][r] = v; mx = fmaxf(mx, v);
                    }
                } else {
#pragma unroll
                    for (int r = 0; r < 16; ++r) s[js][r] = NEG;
                }
                asm volatile("" ::: "memory");
            }
            { float lo_, up_; halves(mx, lo_, up_); mx = fmaxf(lo_, up_); }
            float l = 0.f;
            f32x16 o0, o1;
#pragma unroll
            for (int r = 0; r < 16; ++r) { o0[r] = 0.f; o1[r] = 0.f; }
#pragma unroll
            for (int js = 0; js < 5; ++js) {
                unsigned pw[8];
#pragma unroll
                for (int r = 0; r < 16; r += 2) { const float p0 = __builtin_amdgcn_exp2f(s[js][r] - mx), p1 = __builtin_amdgcn_exp2f(s[js][r + 1] - mx); l += p0 + p1; pw[r >> 1] = cvtpk(p0, p1); }
#pragma unroll
                for (int kk = 0; kk < 2; ++kk) {
                    const v4u pv = {pw[4 * kk], pw[4 * kk + 1], pw[4 * kk + 2], pw[4 * kk + 3]};
                    const bf16x8 pb = __builtin_bit_cast(bf16x8, pv);
#pragma unroll
                    for (int dh = 0; dh < 2; ++dh) {
                        const LAS unsigned char* vp = vl + (32 * dh + l32) * VROW + (32 * (tb + js) + 16 * kk + 4 * hi) * 2;
                        const u32x2 lo = *(const LAS u32x2*)vp, hi2 = *(const LAS u32x2*)(vp + 16);
                        const v4u av = {lo[0], lo[1], hi2[0], hi2[1]};
                        const bf16x8 a = __builtin_bit_cast(bf16x8, av);
                        if (dh == 0) o0 = SB_MFMA(a, pb, o0); else o1 = SB_MFMA(a, pb, o1);
                    }
                }
                asm volatile("" ::: "memory");
            }
            { float lo_, up_; halves(l, lo_, up_); l = lo_ + up_; }
            l += __builtin_amdgcn_exp2f(sink - mx);
            const float il = 1.0f / l;
            bf16* op = O + qrow * D + hq * 64 + 4 * hi;
#pragma unroll
            for (int gg = 0; gg < 4; ++gg) {
                const u32x2 a = {cvtpk(o0[4 * gg] * il, o0[4 * gg + 1] * il), cvtpk(o0[4 * gg + 2] * il, o0[4 * gg + 3] * il)}, c = {cvtpk(o1[4 * gg] * il, o1[4 * gg + 1] * il), cvtpk(o1[4 * gg + 2] * il, o1[4 * gg + 3] * il)};
                *(u32x2*)(op + 8 * gg) = a; *(u32x2*)(op + 32 + 8 * gg) = c; }
        }
    }
}
#undef SW_LOADQ
}

#define XB_TMO      128
#define XB_XCNT(j)  (256  + 64 * (j))
#define XB_XSUB(j)  (1280 + 64 * (j))
#define XB_XGEN(j)  (2304 + 64 * (j))
#define XB_TOP      3328
#define XB_TOPGEN   3392
#define XCD_BAR_WORDS 3456
#define XB_SPIN_CAP (1u << 18)

__device__ __forceinline__ unsigned xb_ld(unsigned* p)              { return __hip_atomic_load(p, __ATOMIC_RELAXED, __HIP_MEMORY_SCOPE_AGENT); }
__device__ __forceinline__ unsigned xb_add(unsigned* p, unsigned v) { return __hip_atomic_fetch_add(p, v, __ATOMIC_RELAXED, __HIP_MEMORY_SCOPE_AGENT); }
__device__ __forceinline__ unsigned xb_xcc_id() { return (unsigned)__builtin_amdgcn_s_getreg((3 << 11) | 20) & 0xFu; }
#define XB_SPIN(cond, bar) do { unsigned _sp = 0; while (cond) { __builtin_amdgcn_s_sleep(1); \
    if ((++_sp & 255u) == 0u) { if (xb_ld(&(bar)[XB_TMO])) break; if (_sp > XB_SPIN_CAP) { atomicAdd(&(bar)[XB_TMO], 1u); break; } } } } while (0)

struct XcdBarrier {
    unsigned* bar; unsigned x;
    volatile LAS unsigned* st;
};

__device__ __forceinline__ XcdBarrier xcd_barrier_post(unsigned* bar, volatile LAS unsigned* st) {
    XcdBarrier b; b.bar = bar; b.x = xb_xcc_id(); b.st = st;
    if (threadIdx.x == 0) (void)xb_add(&bar[XB_XCNT(b.x)], 1u);
    return b;
}
__device__ __forceinline__ void xcd_barrier_complete(unsigned* bar, unsigned x, unsigned& nloc, unsigned& nx) {
    const unsigned G = gridDim.x * gridDim.y * gridDim.z;
    unsigned sum, cnt, mine, sp = 0u;
    for (;;) {
        sum = 0u; cnt = 0u; mine = 0u;
#pragma unroll
        for (unsigned j = 0; j < 16; ++j) { const unsigned c = xb_ld(&bar[XB_XCNT(j)]); sum += c; cnt += (c > 0u) ? 1u : 0u; mine = (j == x) ? c : mine; }
        if (sum == G) break;
        __builtin_amdgcn_s_sleep(1);
        if ((++sp & 255u) == 0u) { if (xb_ld(&bar[XB_TMO])) break; if (sp > XB_SPIN_CAP) { atomicAdd(&bar[XB_TMO], 1u); break; } }
    }
    nloc = mine > 0u ? mine : 1u; nx = cnt > 0u ? cnt : 1u;
}

__device__ __forceinline__ void xcd_barrier(const XcdBarrier& b) {
    asm volatile("s_waitcnt vmcnt(0)" ::: "memory");
    __syncthreads();
    if (threadIdx.x == 0) {
        unsigned* bar = b.bar;
        __builtin_amdgcn_s_waitcnt(0);
        unsigned nloc = b.st[0], nx = b.st[1];
        if (nloc == 0u) { xcd_barrier_complete(bar, b.x, nloc, nx); b.st[0] = nloc; b.st[1] = nx; }
        const unsigned old = xb_add(&bar[XB_XSUB(b.x)], 1u);
        const unsigned gen = old / nloc;
        if (old + 1u == (gen + 1u) * nloc) {
            __builtin_amdgcn_fence(__ATOMIC_RELEASE, "agent");
            asm volatile("s_waitcnt vmcnt(0)" ::: "memory");
            const unsigned og = xb_add(&bar[XB_TOP], 1u);
            const unsigned tg = og / nx;
            if (og + 1u == (tg + 1u) * nx) xb_add(&bar[XB_TOPGEN], 1u);
            else XB_SPIN(xb_ld(&bar[XB_TOPGEN]) == tg, bar);
            __builtin_amdgcn_fence(__ATOMIC_ACQUIRE, "agent");
            xb_add(&bar[XB_XGEN(b.x)], 1u);
            asm volatile("s_waitcnt vmcnt(0)" ::: "memory");
        } else {
            XB_SPIN(xb_ld(&bar[XB_XGEN(b.x)]) == gen, bar);
            __builtin_amdgcn_fence(__ATOMIC_ACQUIRE, "agent");
            asm volatile("s_waitcnt vmcnt(0)" ::: "memory");
        }
    }
    __syncthreads();
}

template <class Sched>
__device__ __forceinline__ pg8::RstdTab fill_rstd_table(const Sched& S, const float* part, LAS unsigned char* lds, int tid) {
    LAS float* tab = (LAS float*)(lds + 131072);
    pg8::RstdTab rt{tab, -1, -1, -1, -1}; int n = 0; pg8::Unit uu;
    for (int i = 0; S.next(i, uu); ++i) {
        if (uu.pm == rt.p0 || uu.pm == rt.p1 || uu.pm == rt.p2 || uu.pm == rt.p3 || n >= 4) continue;
        if (tid < 256) tab[n * 256 + tid] = pg8::row_rstd(part, uu.pm * 256 + tid);
        if (n == 0) rt.p0 = uu.pm; else if (n == 1) rt.p1 = uu.pm; else if (n == 2) rt.p2 = uu.pm; else rt.p3 = uu.pm;
        ++n;
    }
    __syncthreads();
    return rt;
}

constexpr int NPHASES = 1 + 7 * DEPTH;
#ifndef RPT_GU
#define RPT_GU 1
#endif
#ifndef RPT_QKV
#define RPT_QKV 1
#endif
#ifndef RPT_SB
#define RPT_SB 1
#endif
#ifndef RPT_SW
#define RPT_SW 1
#endif
#ifndef RPT_SYNC
#define RPT_SYNC 1
#endif
#ifndef RPT_DOWN
#define RPT_DOWN 1
#endif
#ifndef RPT_WOUT
#define RPT_WOUT 1
#endif
#ifndef RPT_PRO
#define RPT_PRO 1
#endif
__global__ void __launch_bounds__(NTHR, 2) fwd_megakernel(Args a) {
    extern __shared__ __attribute__((aligned(16))) unsigned char lds[];
    cg::grid_group grid = cg::this_grid();
    LAS unsigned char* ldsl = (LAS unsigned char*)lds;
    unsigned char* ws = a.ws;
    bf16* XB = (bf16*)(ws + WS_XB); unsigned char* XL = ws + WS_XL; float* part = (float*)(ws + WS_PART); float* rope = (float*)(ws + WS_ROPE);
    bf16* ACT = (bf16*)(ws + WS_ACT); bf16* QKV = (bf16*)(ws + WS_QKV); bf16* OB = (bf16*)(ws + WS_O);
    volatile LAS unsigned* MISC = (volatile LAS unsigned*)(ldsl + MISC_OFF);
    if (threadIdx.x < 32) MISC[threadIdx.x] = 0u;
    __syncthreads();
    XcdBarrier bar = xcd_barrier_post((unsigned*)(ws + WS_CTL), MISC + 8);
    int ph0 = a.ph_lo; const int ph1 = a.ph_hi;
    float* const outp = a.out;
    if (ph0 == 0) {
        int tid = threadIdx.x; asm volatile("" : "+v"(tid));
        for (int rep = 0; rep < RPT_PRO; ++rep) prologue(a, ldsl, __builtin_amdgcn_readfirstlane(tid >> 6), tid & 63);
        ph0 = 1;
        if (ph1 > NPHASES) grid.sync();
        if (ph0 < ph1) xcd_barrier(bar);
    }
    const float* small = (const float*)(ws + WS_SMALL);
    for (int ph = ph0; ph < ph1; ++ph) {
        int tid = threadIdx.x; asm volatile("" : "+v"(tid));
        {
            const int l = (ph - 1) / 7, k = (ph - 1) % 7, slot = l >> 1; const bool sb = (l & 1) == 0;
            if (k == 0 || k == 5) {
                const int j = k == 0 ? 0 : 1;
                pg8::Gemm g{XB, (const bf16*)(ws + WS_WGU) + (size_t)(l * 2 + j) * NGU * D, M, NGU, D}; pg8::StaticOrder S; S.init(M, NGU, gridDim.x, blockIdx.x);
                const pg8::RstdTab rt = fill_rstd_table(S, part, ldsl, tid);
                pg8::EpiAct E{ACT, FF, rt};
                for (int rep = 0; rep < RPT_GU; ++rep) pg8::gemm_phase<pg8::EpiAct, pg8::StaticOrder, true, true>(ldsl, g, S, E);
            } else if (k == 1 || k == 6) {
                const int j = k == 1 ? 0 : 1;
                pg8::Gemm g{ACT, (const bf16*)(ws + WS_WD) + (size_t)(l * 2 + j) * D * FF, M, D, FF}; pg8::StaticOrder S; S.init(M, D, gridDim.x, blockIdx.x);
                for (int rep = 0; rep < RPT_DOWN; ++rep) { pg8::EpiRes E{XB, XL, part, (ph == NPHASES - 1 && rep == RPT_DOWN - 1) ? outp : nullptr, rep == RPT_DOWN - 1 ? 0.5f : 0.0f};
                pg8::gemm_phase<pg8::EpiRes, pg8::StaticOrder, true, true>(ldsl, g, S, E); }
            } else if (k == 2) {
                const int N = sb ? SBN : SWN;
                pg8::Gemm g{XB, sb ? (const bf16*)(ws + WS_SBIN) + (size_t)slot * SBN * D : (const bf16*)(ws + WS_SWIN) + (size_t)slot * SWN * D, M, N, D};
                pg8::StaticOrder S; S.init(M, N, gridDim.x, blockIdx.x);
                const pg8::RstdTab rt = fill_rstd_table(S, part, ldsl, tid);
                pg8::EpiStore E{QKV, N, rt, sb ? 1024 : 0, 0.125f * 1.4426950408889634f};
                for (int rep = 0; rep < RPT_QKV; ++rep) pg8::gemm_phase<pg8::EpiStore, pg8::StaticOrder, true, true>(ldsl, g, S, E);
            } else if (k == 3) {
                if (sb) { for (int rep = 0; rep < RPT_SB; ++rep) sbat::sb_attn(QKV, OB, ldsl, tid); }
                else for (int rep = 0; rep < RPT_SW; ++rep) swat::sw_attn(QKV, rope, small + slot * HD, small + 128 + slot * HD, small + 256 + slot * 16, OB, ldsl, tid);
            } else {
                pg8::Gemm g{OB, sb ? (const bf16*)(ws + WS_SBOUT) + (size_t)slot * D * D : (const bf16*)(ws + WS_SWOUT) + (size_t)slot * D * D, M, D, D};
                pg8::StaticOrder S; S.init(M, D, gridDim.x, blockIdx.x);
                for (int rep = 0; rep < RPT_WOUT; ++rep) { pg8::EpiRes E{XB, XL, part, nullptr, rep == RPT_WOUT - 1 ? 1.0f : 0.0f};
                pg8::gemm_phase<pg8::EpiRes, pg8::StaticOrder, true, true>(ldsl, g, S, E); }
            }
        }
        if (ph + 1 < ph1) { for (int rep = 0; rep < RPT_SYNC; ++rep) xcd_barrier(bar); }
    }
}

#ifndef MK_PER_PHASE
#define MK_PER_PHASE 0
#endif
extern "C" void kernel_launch(void* const* d_in, const int* in_sizes, int n_in, void* d_out, int out_size, void* d_ws, size_t ws_size, hipStream_t stream) {
    static int grid = 0;
    if (grid == 0) {
        if (n_in != 12 || in_sizes[0] != M * D || out_size != M * D || ws_size < WS_END) { fprintf(stderr, "kernel_launch: unexpected shapes (n_in %d, ws %zu)\n", n_in, ws_size); grid = -1; return; }
        int dev = 0, cus = 0, per_cu = 0;
        hipGetDevice(&dev); hipDeviceGetAttribute(&cus, hipDeviceAttributeMultiprocessorCount, dev);
        if (hipFuncSetAttribute((const void*)fwd_megakernel, hipFuncAttributeMaxDynamicSharedMemorySize, LDS_BYTES) != hipSuccess) { fprintf(stderr, "kernel_launch: hipFuncSetAttribute failed\n"); grid = -1; return; }
        if (hipOccupancyMaxActiveBlocksPerMultiprocessor(&per_cu, (const void*)fwd_megakernel, NTHR, LDS_BYTES) != hipSuccess || per_cu < 1) { fprintf(stderr, "kernel_launch: occupancy query says %d\n", per_cu); per_cu = 1; }
        (void)hipGetLastError();
        grid = cus * 1;
    }
    if (grid < 0) return;
    if (hipMemsetAsync((char*)d_ws + WS_CTL, 0, CTL_ZERO_BYTES, stream) != hipSuccess) { fprintf(stderr, "kernel_launch: memset failed\n"); return; }
    Args a{};
    a.x = (const float*)d_in[0]; a.pos = (const int*)d_in[1]; a.gains = (const float*)d_in[2]; a.wgu = (const float*)d_in[3]; a.wd = (const float*)d_in[4];
    a.sbin = (const float*)d_in[5]; a.sbout = (const float*)d_in[6]; a.swin = (const float*)d_in[7]; a.swout = (const float*)d_in[8];
    a.qg = (const float*)d_in[9]; a.kg = (const float*)d_in[10]; a.sinks = (const float*)d_in[11];
    a.out = (float*)d_out; a.ws = (unsigned char*)d_ws;
#if MK_PER_PHASE
    for (int ph = 0; ph < NPHASES; ++ph) { a.ph_lo = ph; a.ph_hi = ph + 1; hipLaunchKernelGGL(fwd_megakernel, dim3(grid), dim3(NTHR), LDS_BYTES, stream, a); }
#else
    a.ph_lo = 0; a.ph_hi = NPHASES;
    void* args[] = {&a};
    hipError_t e = hipLaunchCooperativeKernel((const void*)fwd_megakernel, dim3(grid), dim3(NTHR), args, LDS_BYTES, stream);
    if (e != hipSuccess) fprintf(stderr, "cooperative launch failed: %s (grid %d)\n", hipGetErrorString(e), grid);
#endif
}
```

```cpp
#include <hip/hip_runtime.h>
#include <hip/hip_cooperative_groups.h>
#include <cstdio>
#include <cstdint>
namespace cg = cooperative_groups;
namespace pg8 {
#define PG8_LAS __attribute__((address_space(3)))
typedef unsigned short bf16_t;
typedef short bf16x8 __attribute__((ext_vector_type(8)));
typedef float f32x4 __attribute__((ext_vector_type(4)));
typedef unsigned u32x4 __attribute__((ext_vector_type(4)));
constexpr int BM = 256, BK = 64, HALF = 128, HTB = HALF * BK * 2  , STAGE_BYTES = 8 * HTB, NXCD = 8, WGM = 8;

__host__ __device__ __forceinline__ int lds_byte(int r, int c) { const int st = (r >> 4) * 2 + (c >> 5), rr = r & 15, cc = c & 31, ob = rr * 64 + cc * 2; return st * 1024 + (ob ^ (((ob >> 9) & 1) << 5)); }
__host__ __device__ __forceinline__ void stage_rc(int b, int& R, int& C) { const int st = b / 1024, sb = b % 1024, swz = sb ^ (((sb >> 9) & 1) << 5); R = (st >> 1) * 16 + swz / 64; C = (st & 1) * 32 + (swz % 64) / 2; }
__host__ __device__ __forceinline__ int perm32(int rho) { const int n = rho >> 4, i = rho & 15; return 8 * (i >> 2) + 4 * n + (i & 3); }

struct Unit { int pm, pn; };
struct Gemm { const bf16_t* A; const bf16_t* Bt; int M, N, K; };

struct StaticOrder {
    int nM, nN, nwg, G, c;
    __host__ __device__ void init(int M, int N, int G_, int c_) { nM = M / BM; nN = N / BM; nwg = nM * nN; G = G_; c = c_; }
    __host__ __device__ bool next(int i, Unit& u) const {
        const long L = (long)i * G + c; if (L >= nwg) return false;
        int wgid = (int)L; { const int q = nwg / NXCD, r = nwg % NXCD, xcd = wgid % NXCD, off = wgid / NXCD; wgid = (xcd < r ? xcd * (q + 1) : r * (q + 1) + (xcd - r) * q) + off; }
        const int nig = WGM * nN, gid = wgid / nig, fm = gid * WGM, gsz = (nM - fm) < WGM ? (nM - fm) : WGM;
        u.pm = fm + ((wgid % nig) % gsz); u.pn = (wgid % nig) / gsz; return true;
    }
    __device__ __forceinline__ void a_ready(const Unit&) const {}
    __device__ __forceinline__ void done(const Unit&) const {}
};

__device__ __forceinline__ unsigned cvt_pk_bf16(float lo, float hi) { unsigned r; asm volatile("v_cvt_pk_bf16_f32 %0, %1, %2" : "=v"(r) : "v"(lo), "v"(hi)); return r; }
typedef unsigned u32x4e __attribute__((ext_vector_type(4)));
constexpr float RMS_EPS = 1e-6f;
__device__ __forceinline__ float shx(float v, int lane, int m) { return __builtin_bit_cast(float, __builtin_amdgcn_ds_bpermute((lane ^ m) << 2, __builtin_bit_cast(int, v))); }
__device__ __forceinline__ float row_rstd(const float* part, int row) {
    const f32x4* p = (const f32x4*)(part + (size_t)row * 16);
    const f32x4 a = p[0], b = p[1], c = p[2], d = p[3];
    const float s = ((a[0] + a[1]) + (a[2] + a[3])) + ((b[0] + b[1]) + (b[2] + b[3])) + ((c[0] + c[1]) + (c[2] + c[3])) + ((d[0] + d[1]) + (d[2] + d[3]));
    return __builtin_amdgcn_rsqf(s * (1.0f / 1024.0f) + RMS_EPS);
}
__device__ __forceinline__ float silu_mul(float g, float u) { return g * u * __builtin_amdgcn_rcpf(1.0f + __builtin_amdgcn_exp2f(-1.4426950408889634f * g)); }

struct RstdTab { const PG8_LAS float* tab; int p0, p1, p2, p3;
    __device__ __forceinline__ const PG8_LAS float* rows(int pm) const { const int slot = pm == p0 ? 0 : pm == p1 ? 1 : pm == p2 ? 2 : 3; return tab + slot * 256; } };
struct EpiAct {
    static constexpr bool PERM = true, AFTER_DRAIN = false;
    bf16_t* O; int ldo; RstdTab rt;
    __device__ __forceinline__ void operator()(const f32x4 (&acc)[2][2][4][2], const Unit& u, int wr, int wc, int fr, int fq) const {
        const int row0 = u.pm * BM + wr * 64 + fr, col0 = u.pn * HALF + wc * 32 + 8 * fq;
        float rsv[8]; { const PG8_LAS float* t_ = rt.rows(u.pm) + wr * 64 + fr;
#pragma unroll
            for (int it = 0; it < 8; ++it) rsv[it] = t_[(it >> 2) * HALF + (it & 3) * 16]; }
#pragma unroll
        for (int ai = 0; ai < 2; ++ai)
#pragma unroll
            for (int m = 0; m < 4; ++m) {
                const int row = row0 + ai * HALF + m * 16; const float rs = rsv[ai * 4 + m];
                const f32x4 g0 = acc[ai][0][m][0] * rs, g1 = acc[ai][0][m][1] * rs, u0 = acc[ai][1][m][0] * rs, u1 = acc[ai][1][m][1] * rs;
                u32x4e w;
                w.x = cvt_pk_bf16(silu_mul(g0[0], u0[0]), silu_mul(g0[1], u0[1])); w.y = cvt_pk_bf16(silu_mul(g0[2], u0[2]), silu_mul(g0[3], u0[3]));
                w.z = cvt_pk_bf16(silu_mul(g1[0], u1[0]), silu_mul(g1[1], u1[1])); w.w = cvt_pk_bf16(silu_mul(g1[2], u1[2]), silu_mul(g1[3], u1[3]));
                *(u32x4e*)(O + (size_t)row * ldo + col0) = w;
                asm volatile("" ::: "memory");
            }
    }
};
struct EpiStore {
    static constexpr bool PERM = true, AFTER_DRAIN = false;
    bf16_t* O; int ldo; RstdTab rt; int qcols; float qscale;
    __device__ __forceinline__ void operator()(const f32x4 (&acc)[2][2][4][2], const Unit& u, int wr, int wc, int fr, int fq) const {
        const int row0 = u.pm * BM + wr * 64 + fr, col0 = u.pn * BM + wc * 32 + 8 * fq;
        const float cs = (u.pn * BM < qcols) ? qscale : 1.0f;
        float rsv[8]; { const PG8_LAS float* t_ = rt.rows(u.pm) + wr * 64 + fr;
#pragma unroll
            for (int it = 0; it < 8; ++it) rsv[it] = t_[(it >> 2) * HALF + (it & 3) * 16] * cs; }
#pragma unroll
        for (int ai = 0; ai < 2; ++ai)
#pragma unroll
            for (int m = 0; m < 4; ++m) {
                const int row = row0 + ai * HALF + m * 16; const float rs = rsv[ai * 4 + m];
#pragma unroll
                for (int bj = 0; bj < 2; ++bj) {
                    const f32x4 v0 = acc[ai][bj][m][0] * rs, v1 = acc[ai][bj][m][1] * rs; u32x4e w;
                    w.x = cvt_pk_bf16(v0[0], v0[1]); w.y = cvt_pk_bf16(v0[2], v0[3]); w.z = cvt_pk_bf16(v1[0], v1[1]); w.w = cvt_pk_bf16(v1[2], v1[3]);
                    { const int col = col0 + bj * HALF; *(u32x4e*)(O + ((size_t)((row >> 12) * (ldo >> 6) + (col >> 6)) * 4096 + (row & 4095)) * 64 + (col & 63)) = w; }
                }
                asm volatile("" ::: "memory");
            }
    }
};
__device__ __forceinline__ float bfl(unsigned w) { return __builtin_bit_cast(float, w << 16); }
__device__ __forceinline__ float bfh(unsigned w) { return __builtin_bit_cast(float, w & 0xffff0000u); }
typedef unsigned u32x2e __attribute__((ext_vector_type(2)));
typedef float f32x2e __attribute__((ext_vector_type(2)));
__device__ __forceinline__ unsigned lo8_pack(float a, float b, float c, float d) { int w = __builtin_amdgcn_cvt_pk_fp8_f32(a, b, 0, false); w = __builtin_amdgcn_cvt_pk_fp8_f32(c, d, w, true); return (unsigned)w; }
struct EpiRes {
    static constexpr bool PERM = true, AFTER_DRAIN = false;
    bf16_t* XH; unsigned char* XL; float* part; float* OUT; float alpha;
    __device__ __forceinline__ void operator()(const f32x4 (&acc)[2][2][4][2], const Unit& u, int wr, int wc, int fr, int fq) const {
        const int row0 = u.pm * BM + wr * 64 + fr, col0 = u.pn * BM + wc * 32 + 8 * fq;
        bf16_t* const xh_ = XH; unsigned char* const xl_ = XL; float* const part_ = part; const float alpha_ = alpha; float* const out_ = OUT;
        constexpr int ER_DEPTH = 4;
        float ssv[8];
        u32x4e hb[ER_DEPTH][2]; u32x2e lb[ER_DEPTH][2];
#define ER_LOAD(it_, buf_) do { const size_t o_ = (size_t)(row0 + ((it_) >> 2) * HALF + ((it_) & 3) * 16) * 1024 + col0; \
            hb[buf_][0] = *(const u32x4e*)(xh_ + o_); lb[buf_][0] = *(const u32x2e*)(xl_ + o_); hb[buf_][1] = *(const u32x4e*)(xh_ + o_ + HALF); lb[buf_][1] = *(const u32x2e*)(xl_ + o_ + HALF); } while (0)
#pragma unroll
        for (int it = 0; it < ER_DEPTH - 1; ++it) ER_LOAD(it, it);
#pragma unroll
        for (int it = 0; it < 8; ++it) {
            const int cur = it % ER_DEPTH, ai = it >> 2, m = it & 3;
            if (it + ER_DEPTH - 1 < 8) ER_LOAD(it + ER_DEPTH - 1, (it + ER_DEPTH - 1) % ER_DEPTH);
            asm volatile("" ::: "memory");
            const int row = row0 + ai * HALF + m * 16; float ss = 0.f;
#pragma unroll
            for (int bj = 0; bj < 2; ++bj) {
                const u32x4e hw = hb[cur][bj]; const u32x2e lw = lb[cur][bj];
                const f32x2e l0 = __builtin_amdgcn_cvt_pk_f32_fp8((int)lw.x, false), l1 = __builtin_amdgcn_cvt_pk_f32_fp8((int)lw.x, true), l2 = __builtin_amdgcn_cvt_pk_f32_fp8((int)lw.y, false), l3 = __builtin_amdgcn_cvt_pk_f32_fp8((int)lw.y, true);
                constexpr float IS = 1.0f / 256.0f;
                f32x4 x0 = {fmaf(l0[0], IS, bfl(hw.x)), fmaf(l0[1], IS, bfh(hw.x)), fmaf(l1[0], IS, bfl(hw.y)), fmaf(l1[1], IS, bfh(hw.y))};
                f32x4 x1 = {fmaf(l2[0], IS, bfl(hw.z)), fmaf(l2[1], IS, bfh(hw.z)), fmaf(l3[0], IS, bfl(hw.w)), fmaf(l3[1], IS, bfh(hw.w))};
                x0 += acc[ai][bj][m][0] * alpha_; x1 += acc[ai][bj][m][1] * alpha_;
                const size_t o = (size_t)row * 1024 + col0 + bj * HALF;
                if (out_) { *(f32x4*)(out_ + o) = x0; *(f32x4*)(out_ + o + 4) = x1; }
                else {
                    ss += (x0[0] * x0[0] + x0[1] * x0[1]) + (x0[2] * x0[2] + x0[3] * x0[3]) + (x1[0] * x1[0] + x1[1] * x1[1]) + (x1[2] * x1[2] + x1[3] * x1[3]);
                    u32x4e w; w.x = cvt_pk_bf16(x0[0], x0[1]); w.y = cvt_pk_bf16(x0[2], x0[3]); w.z = cvt_pk_bf16(x1[0], x1[1]); w.w = cvt_pk_bf16(x1[2], x1[3]);
                    u32x2e v; v.x = lo8_pack((x0[0] - bfl(w.x)) * 256.0f, (x0[1] - bfh(w.x)) * 256.0f, (x0[2] - bfl(w.y)) * 256.0f, (x0[3] - bfh(w.y)) * 256.0f);
                    v.y = lo8_pack((x1[0] - bfl(w.z)) * 256.0f, (x1[1] - bfh(w.z)) * 256.0f, (x1[2] - bfl(w.w)) * 256.0f, (x1[3] - bfh(w.w)) * 256.0f);
                    *(u32x4e*)(xh_ + o) = w; *(u32x2e*)(xl_ + o) = v;
                }
            }
            ssv[it] = ss;
        }
#undef ER_LOAD
        if (!out_) {
            const int ln = fr + 16 * fq;
#pragma unroll
            for (int it = 0; it < 8; ++it) ssv[it] += shx(ssv[it], ln, 16);
#pragma unroll
            for (int it = 0; it < 8; ++it) ssv[it] += shx(ssv[it], ln, 32);
            if (fq == 0) {
#pragma unroll
                for (int it = 0; it < 8; ++it) part_[(size_t)(row0 + (it >> 2) * HALF + (it & 3) * 16) * 16 + u.pn * 4 + wc] = ssv[it];
            }
        }
    }
};
template <class Epi, class Sched, bool ALIGN_EPI = false, bool SP2 = false>
__device__ __forceinline__ void gemm_phase(PG8_LAS unsigned char* lds, const Gemm g, const Sched& S, const Epi& E) {
    int tid_ = threadIdx.x; asm volatile("" : "+v"(tid_));
    const int tid = tid_, wid = __builtin_amdgcn_readfirstlane(tid >> 6), lane = tid & 63, wr = wid >> 2, wc = wid & 3, fr = lane & 15, fq = lane >> 4;
    const int K = g.K, nt = K / BK;
    unsigned voffA[2], voffB[2];
#pragma unroll
    for (int i = 0; i < 2; ++i) { int R, C; stage_rc(tid * 16 + i * 8192, R, C); const int Rb = Epi::PERM ? ((R & ~31) + perm32(R & 31)) : R;
        voffA[i] = (unsigned)(R * K + C) * 2u; voffB[i] = (unsigned)(Rb * K + C) * 2u; }
    const size_t kstep = (size_t)(BK * 2);
    const size_t hstep = (size_t)HALF * K * 2;
    const size_t tstep = 2 * hstep;
    const unsigned ldsw = (unsigned)wid * 1024u;
    const int aoff = lds_byte(wr * 64 + fr, fq * 8), boff = lds_byte(wc * 32 + fr, fq * 8);
#define PG8_SA(b, h) (((b) * 2 + (h)) * HTB)
#define PG8_SB(b, h) ((4 + (b) * 2 + (h)) * HTB)
#define PG8_STAGE(bufoff, gbase, voff) do { _Pragma("unroll") for (int _i = 0; _i < 2; ++_i) \
        __builtin_amdgcn_global_load_lds((const unsigned*)((const char*)(gbase) + (voff)[_i]), (PG8_LAS unsigned*)(lds + (bufoff) + ldsw + _i * 8192), 16, 0, 0); } while (0)
#define PG8_LDA(dst, b, h) do { _Pragma("unroll") for (int m = 0; m < 4; ++m) _Pragma("unroll") for (int k = 0; k < 2; ++k) dst[m][k] = *(const PG8_LAS bf16x8*)(lds + PG8_SA(b, h) + aoff + m * 2048 + k * 1024); } while (0)
#define PG8_LDB(dst, b, h) do { _Pragma("unroll") for (int n = 0; n < 2; ++n) _Pragma("unroll") for (int k = 0; k < 2; ++k) dst[n][k] = *(const PG8_LAS bf16x8*)(lds + PG8_SB(b, h) + boff + n * 2048 + k * 1024); } while (0)
#define PG8_MMA(ai, bj, At, Bt) do { __builtin_amdgcn_s_setprio(1); _Pragma("unroll") for (int m = 0; m < 4; ++m) _Pragma("unroll") for (int n = 0; n < 2; ++n) _Pragma("unroll") for (int k = 0; k < 2; ++k) \
        acc[ai][bj][m][n] = __builtin_amdgcn_mfma_f32_16x16x32_bf16(Bt[n][k], At[m][k], acc[ai][bj][m][n], 0, 0, 0); __builtin_amdgcn_s_setprio(0); } while (0)
#define PG8_WAIT_V(n) asm volatile("s_waitcnt vmcnt(" #n ")" ::: "memory")
#define PG8_WAIT_L(n) asm volatile("s_waitcnt lgkmcnt(" #n ")" ::: "memory")
#define PG8_BAR __builtin_amdgcn_s_barrier()
#define PG8_SCHED __builtin_amdgcn_sched_barrier(0)
    Unit cur, nxt; int ui = 0;
    if (!S.next(0, cur)) return;
    f32x4 acc[2][2][4][2];
#pragma unroll
    for (int a = 0; a < 2; ++a)
#pragma unroll
        for (int b = 0; b < 2; ++b)
#pragma unroll
            for (int m = 0; m < 4; ++m)
#pragma unroll
                for (int n = 0; n < 2; ++n) acc[a][b][m][n] = (f32x4){0.f, 0.f, 0.f, 0.f};
    bf16x8 At[4][2], B0[2][2], B1[2][2];
    const char* cA = (const char*)g.A + (size_t)cur.pm * tstep; const char* cB = (const char*)g.Bt + (size_t)cur.pn * tstep;
    S.a_ready(cur);
    if constexpr (SP2) {
        PG8_STAGE(PG8_SB(0, 0), cB, voffB); PG8_STAGE(PG8_SB(0, 1), cB + hstep, voffB); PG8_STAGE(PG8_SA(0, 0), cA, voffA); PG8_STAGE(PG8_SA(0, 1), cA + hstep, voffA);
        if (wr == 1) PG8_BAR;
        PG8_WAIT_V(2); PG8_BAR;
        PG8_STAGE(PG8_SB(1, 0), cB + kstep, voffB); PG8_STAGE(PG8_SA(1, 0), cA + kstep, voffA); PG8_STAGE(PG8_SB(1, 1), cB + hstep + kstep, voffB);
        PG8_WAIT_V(6); PG8_BAR;
    } else {
        PG8_STAGE(PG8_SB(0, 0), cB, voffB); PG8_STAGE(PG8_SA(0, 0), cA, voffA); PG8_STAGE(PG8_SB(0, 1), cB + hstep, voffB); PG8_STAGE(PG8_SA(0, 1), cA + hstep, voffA);
        if (wr == 1) PG8_BAR;
        PG8_WAIT_V(4); PG8_BAR;
        PG8_STAGE(PG8_SB(1, 0), cB + kstep, voffB); PG8_STAGE(PG8_SA(1, 0), cA + kstep, voffA); PG8_STAGE(PG8_SB(1, 1), cB + hstep + kstep, voffB);
        PG8_WAIT_V(6); PG8_BAR;
    }
    for (;;) {
        const bool has_next = S.next(ui + 1, nxt);
        const char* nA = has_next ? (const char*)g.A + (size_t)nxt.pm * tstep : cA; const char* nB = has_next ? (const char*)g.Bt + (size_t)nxt.pn * tstep : cB;
        for (int t = 0; t < nt; t += 2) {
            const bool last = (t == nt - 2);
            const char* a1 = cA + (size_t)(t + 1) * kstep;
            const char* a2 = last ? nA : cA + (size_t)(t + 2) * kstep; const char* b2 = last ? nB : cB + (size_t)(t + 2) * kstep;
            const char* a3 = a2 + kstep; const char* b3 = b2 + kstep;
            if (last && has_next) S.a_ready(nxt);
            if constexpr (SP2) {
            PG8_LDB(B0, 0, 0); PG8_LDB(B1, 0, 1); PG8_SCHED; PG8_LDA(At, 0, 0); PG8_STAGE(PG8_SA(1, 1), a1 + hstep, voffA);
            PG8_WAIT_V(8); PG8_WAIT_L(0); PG8_BAR; PG8_MMA(0, 0, At, B0); PG8_MMA(0, 1, At, B1); PG8_BAR; PG8_SCHED;
            PG8_LDA(At, 0, 1); PG8_STAGE(PG8_SB(0, 0), b2, voffB); PG8_STAGE(PG8_SB(0, 1), b2 + hstep, voffB); PG8_STAGE(PG8_SA(0, 0), a2, voffA);
            PG8_WAIT_V(8); PG8_WAIT_L(0); PG8_BAR; PG8_MMA(1, 0, At, B0); PG8_MMA(1, 1, At, B1); PG8_BAR; PG8_SCHED;
            PG8_LDB(B0, 1, 0); PG8_LDB(B1, 1, 1); PG8_SCHED; PG8_LDA(At, 1, 0); PG8_STAGE(PG8_SA(0, 1), a2 + hstep, voffA);
            PG8_WAIT_V(8); PG8_WAIT_L(0); PG8_BAR; PG8_MMA(0, 0, At, B0); PG8_MMA(0, 1, At, B1); PG8_BAR; PG8_SCHED;
            PG8_LDA(At, 1, 1); PG8_STAGE(PG8_SB(1, 0), b3, voffB); PG8_STAGE(PG8_SB(1, 1), b3 + hstep, voffB); PG8_STAGE(PG8_SA(1, 0), a3, voffA);
            PG8_WAIT_V(8); PG8_WAIT_L(0); PG8_BAR; PG8_MMA(1, 0, At, B0); PG8_MMA(1, 1, At, B1); PG8_BAR; PG8_SCHED;
            } else {
            PG8_LDB(B0, 0, 0); PG8_SCHED; PG8_LDA(At, 0, 0); PG8_STAGE(PG8_SA(1, 1), a1 + hstep, voffA);
            PG8_WAIT_L(8); PG8_BAR; PG8_WAIT_L(0); PG8_MMA(0, 0, At, B0); PG8_BAR; PG8_SCHED;
            PG8_LDB(B1, 0, 1); PG8_STAGE(PG8_SB(0, 0), b2, voffB);
            PG8_BAR; PG8_WAIT_L(0); PG8_MMA(0, 1, At, B1); PG8_BAR;
            PG8_LDA(At, 0, 1); PG8_STAGE(PG8_SA(0, 0), a2, voffA);
            PG8_BAR; PG8_WAIT_L(0); PG8_MMA(1, 0, At, B0); PG8_BAR; PG8_SCHED;
            PG8_STAGE(PG8_SB(0, 1), b2 + hstep, voffB);
            PG8_WAIT_V(6); PG8_BAR; PG8_MMA(1, 1, At, B1); PG8_BAR;
            PG8_LDB(B0, 1, 0); PG8_SCHED; PG8_LDA(At, 1, 0); PG8_STAGE(PG8_SA(0, 1), a2 + hstep, voffA);
            PG8_WAIT_L(8); PG8_BAR; PG8_WAIT_L(0); PG8_MMA(0, 0, At, B0); PG8_BAR; PG8_SCHED;
            PG8_LDB(B1, 1, 1); PG8_STAGE(PG8_SB(1, 0), b3, voffB);
            PG8_BAR; PG8_WAIT_L(0); PG8_MMA(0, 1, At, B1); PG8_BAR;
            PG8_LDA(At, 1, 1); PG8_STAGE(PG8_SA(1, 0), a3, voffA);
            PG8_BAR; PG8_WAIT_L(0); PG8_MMA(1, 0, At, B0); PG8_BAR; PG8_SCHED;
            PG8_STAGE(PG8_SB(1, 1), b3 + hstep, voffB);
            PG8_WAIT_V(6); PG8_BAR; PG8_MMA(1, 1, At, B1); PG8_BAR;
            }
        }
        if constexpr (ALIGN_EPI) { if (wr == 0) PG8_BAR; }
        if constexpr (!Epi::AFTER_DRAIN) { E(acc, cur, wr, wc, fr, fq); S.done(cur); }
        if (!has_next) break;
#pragma unroll
        for (int a = 0; a < 2; ++a)
#pragma unroll
            for (int b = 0; b < 2; ++b)
#pragma unroll
                for (int m = 0; m < 4; ++m)
#pragma unroll
                    for (int n = 0; n < 2; ++n) acc[a][b][m][n] = (f32x4){0.f, 0.f, 0.f, 0.f};
        cur = nxt; cA = nA; cB = nB; ++ui;
        if constexpr (ALIGN_EPI) { if (wr == 1) PG8_BAR; }
    }
    PG8_WAIT_V(0);
    if constexpr (!ALIGN_EPI) { if (wr == 0) PG8_BAR; }
    PG8_BAR;
    if constexpr (Epi::AFTER_DRAIN) { E.fused(acc, cur, wr, wc, fr, fq, lds, wid, lane); S.done(cur); }
#undef PG8_SA
#undef PG8_SB
#undef PG8_STAGE
#undef PG8_LDA
#undef PG8_LDB
#undef PG8_MMA
#undef PG8_WAIT_V
#undef PG8_WAIT_L
#undef PG8_BAR
#undef PG8_SCHED
}
}

#define LAS __attribute__((address_space(3)))
typedef unsigned short bf16;
typedef unsigned v4u __attribute__((ext_vector_type(4)));
typedef float f32x4 __attribute__((ext_vector_type(4)));
constexpr int NWAVES = 8, NTHR = 512;
constexpr int BATCH = 8, SEQ = 4096, D = 1024, M = BATCH * SEQ, FF = 2816, NGU = 2 * FF, DEPTH = 4;
constexpr int SBN = 3072, SWN = 1280, HD = 64;
constexpr size_t MiB = 1u << 20;
constexpr size_t WS_WGU = 0;
constexpr size_t WS_WD = WS_WGU + 88 * MiB;
constexpr size_t WS_SBIN = WS_WD + 44 * MiB;
constexpr size_t WS_SBOUT = WS_SBIN + 12 * MiB;
constexpr size_t WS_SWIN = WS_SBOUT + 4 * MiB;
constexpr size_t WS_SWOUT = WS_SWIN + 5 * MiB;
constexpr size_t WS_XB = WS_SWOUT + 4 * MiB;
constexpr size_t WS_XL = WS_XB + 64 * MiB;
constexpr size_t WS_PART = WS_XL + 64 * MiB;
constexpr size_t WS_ROPE = WS_PART + 2 * MiB;
constexpr size_t WS_SMALL = WS_ROPE + 2 * MiB;
constexpr size_t WS_ACT = WS_SMALL + 1 * MiB;
constexpr size_t WS_QKV = WS_ACT;
constexpr size_t WS_O = WS_QKV + 192 * MiB;
constexpr size_t WS_CTL = WS_O + 64 * MiB;
constexpr size_t CTL_ZERO_BYTES = 16384;
constexpr size_t WS_END = WS_CTL + 1 * MiB;
constexpr int MISC_OFF = 147456 - 256;
constexpr int LDS_BYTES = 147456;

__device__ __forceinline__ unsigned f2bf(float f) { unsigned u = __builtin_bit_cast(unsigned, f); return (u + 0x7fffu + ((u >> 16) & 1u)) >> 16; }
__device__ __forceinline__ unsigned pk2(float lo, float hi) { return f2bf(lo) | (f2bf(hi) << 16); }
__device__ __forceinline__ float bf_lo(unsigned w) { return __uint_as_float(w << 16); }
__device__ __forceinline__ float bf_hi(unsigned w) { return __uint_as_float(w & 0xffff0000u); }
#define LDS_WAIT() asm volatile("s_waitcnt lgkmcnt(0)" ::: "memory")
__device__ __forceinline__ float wave_sum(float v) {
#pragma unroll
    for (int o = 1; o < 64; o <<= 1) v += __shfl_xor(v, o);
    return v;
}

struct Args {
    const float* x; const int* pos; const float* gains; const float* wgu; const float* wd; const float* sbin; const float* sbout;
    const float* swin; const float* swout; const float* qg; const float* kg; const float* sinks;
    float* out; unsigned char* ws; int ph_lo, ph_hi;
};

__device__ __forceinline__ void transpose_item(const float* W, int K, int N, bf16* WT, int out_row, const float* gain, LAS float* scr, int k0, int n0, int lane) {
    const int r4 = lane >> 4, c4 = (lane & 15) * 4;
    f32x4 wv[16];
#pragma unroll
    for (int i = 0; i < 16; ++i) wv[i] = *(const f32x4*)(W + (size_t)(k0 + 4 * i + r4) * N + n0 + c4);
#pragma unroll
    for (int i = 0; i < 16; ++i) { const int kk = 4 * i + r4; f32x4 v = wv[i]; if (gain) v *= gain[k0 + kk];
        LAS float* d = scr + kk * 65 + c4; d[0] = v[0]; d[1] = v[1]; d[2] = v[2]; d[3] = v[3]; }
    LDS_WAIT(); asm volatile("" ::: "memory");
    const int c = lane & 7;
#pragma unroll
    for (int j = 0; j < 8; ++j) { const int n = (lane >> 3) + 8 * j; const LAS float* s = scr + (8 * c) * 65 + n;
        v4u o; o.x = pk2(s[0 * 65], s[1 * 65]); o.y = pk2(s[2 * 65], s[3 * 65]); o.z = pk2(s[4 * 65], s[5 * 65]); o.w = pk2(s[6 * 65], s[7 * 65]);
        *(v4u*)(WT + (size_t)(out_row + n) * K + k0 + 8 * c) = o; }
    LDS_WAIT(); asm volatile("" ::: "memory");
}
constexpr int IT_GU = (D / 64) * (NGU / 64), IT_DN = (FF / 64) * (D / 64), IT_SBI = (D / 64) * (SBN / 64), IT_SQ = (D / 64) * (D / 64), IT_SWI = (D / 64) * (SWN / 64);
constexpr int IT_END_GU = 8 * IT_GU, IT_END_DN = IT_END_GU + 8 * IT_DN, IT_END_SBI = IT_END_DN + 2 * IT_SBI, IT_END_SBO = IT_END_SBI + 2 * IT_SQ, IT_END_SWI = IT_END_SBO + 2 * IT_SWI, IT_END = IT_END_SWI + 2 * IT_SQ;
__device__ __forceinline__ void prologue(const Args& a, LAS unsigned char* lds, int wave, int lane) {
    LAS float* scr = (LAS float*)(lds + wave * 16640);
    const int gw = blockIdx.x * NWAVES + wave, NGW = gridDim.x * NWAVES;
    unsigned char* ws = a.ws;
    for (int it = gw; it < IT_END; it += NGW) {
        const float* W; bf16* WT; const float* gain = nullptr; int K = D, N, mode = 0, r;
        if (it < IT_END_GU) { const int mi = it / IT_GU; r = it % IT_GU; W = a.wgu + (size_t)mi * D * NGU; WT = (bf16*)(ws + WS_WGU) + (size_t)mi * NGU * D; N = NGU; mode = 1; gain = a.gains + (size_t)((mi >> 1) * 3 + 2 * (mi & 1)) * D; }
        else if (it < IT_END_DN) { const int q = it - IT_END_GU, mi = q / IT_DN; r = q % IT_DN; W = a.wd + (size_t)mi * FF * D; WT = (bf16*)(ws + WS_WD) + (size_t)mi * D * FF; K = FF; N = D; }
        else if (it < IT_END_SBI) { const int q = it - IT_END_DN, s = q / IT_SBI; r = q % IT_SBI; W = a.sbin + (size_t)s * D * SBN; WT = (bf16*)(ws + WS_SBIN) + (size_t)s * SBN * D; N = SBN; gain = a.gains + (size_t)((2 * s) * 3 + 1) * D; }
        else if (it < IT_END_SBO) { const int q = it - IT_END_SBI, s = q / IT_SQ; r = q % IT_SQ; W = a.sbout + (size_t)s * D * D; WT = (bf16*)(ws + WS_SBOUT) + (size_t)s * D * D; N = D; }
        else if (it < IT_END_SWI) { const int q = it - IT_END_SBO, s = q / IT_SWI; r = q % IT_SWI; W = a.swin + (size_t)s * D * SWN; WT = (bf16*)(ws + WS_SWIN) + (size_t)s * SWN * D; N = SWN; gain = a.gains + (size_t)((2 * s + 1) * 3 + 1) * D; }
        else { const int q = it - IT_END_SWI, s = q / IT_SQ; r = q % IT_SQ; W = a.swout + (size_t)s * D * D; WT = (bf16*)(ws + WS_SWOUT) + (size_t)s * D * D; N = D; }
        const int nblk = N / 64, kb = r / nblk, nb = r % nblk, n0 = 64 * nb;
        int orow = n0;
        if (mode == 1) { const int j = n0 < FF ? n0 : n0 - FF; orow = (j / 128) * 256 + (n0 < FF ? 0 : 128) + (j % 128); }
        transpose_item(W, K, N, WT, orow, gain, scr, 64 * kb, n0, lane);
    }
    if (blockIdx.x == 0 && wave == 0) { float* sm = (float*)(ws + WS_SMALL); sm[lane] = a.qg[lane]; sm[64 + lane] = a.qg[64 + lane]; sm[128 + lane] = a.kg[lane]; sm[192 + lane] = a.kg[64 + lane]; if (lane < 32) sm[256 + lane] = a.sinks[lane]; }
    bf16* XB = (bf16*)(ws + WS_XB); unsigned char* XL = ws + WS_XL; float* part = (float*)(ws + WS_PART); float* rope = (float*)(ws + WS_ROPE);
    f32x4 xc[4], xn[4];
    if (gw < M) {
#pragma unroll
        for (int j = 0; j < 4; ++j) xc[j] = ((const f32x4*)(a.x + (size_t)gw * D) + lane)[64 * j]; }
    for (int m = gw; m < M; m += NGW) {
        if (m + NGW < M) {
#pragma unroll
            for (int j = 0; j < 4; ++j) xn[j] = ((const f32x4*)(a.x + (size_t)(m + NGW) * D) + lane)[64 * j]; }
        unsigned long long* b8 = (unsigned long long*)(XB + (size_t)m * D) + lane; unsigned* l8 = (unsigned*)(XL + (size_t)m * D) + lane;
        float s = 0.f;
#pragma unroll
        for (int j = 0; j < 4; ++j) { const f32x4 v = xc[j]; s += (v[0] * v[0] + v[1] * v[1]) + (v[2] * v[2] + v[3] * v[3]);
            const unsigned h0 = pk2(v[0], v[1]), h1 = pk2(v[2], v[3]);
            b8[64 * j] = (unsigned long long)h0 | ((unsigned long long)h1 << 32);
            l8[64 * j] = pg8::lo8_pack((v[0] - bf_lo(h0)) * 256.0f, (v[1] - bf_hi(h0)) * 256.0f, (v[2] - bf_lo(h1)) * 256.0f, (v[3] - bf_hi(h1)) * 256.0f); }
        s = wave_sum(s);
        if (lane < 16) part[(size_t)m * 16 + lane] = lane == 0 ? s : 0.f;
        if (lane < 8) {
            const float invf[8] = {1.0f, 0.1939227432012558f, 0.03760603070259094f, 0.007292664609849453f, 0.0014142135623842478f, 0.00027424818836152554f, 5.318296098266728e-05f, 1.0313386155758053e-05f};
            float fr = invf[0];
#pragma unroll
            for (int i = 1; i < 8; ++i) fr = lane == i ? invf[i] : fr;
            const float ang = (float)a.pos[m] * fr;
            const float k = rintf(ang * 0.15915494309189535f);
            float r = fmaf(-k, 6.2831855f, ang); r = fmaf(-k, -1.7484555e-7f, r);
            const float rev = r * 0.15915494309189535f;
            rope[(size_t)m * 16 + lane] = __builtin_amdgcn_cosf(rev); rope[(size_t)m * 16 + 8 + lane] = __builtin_amdgcn_sinf(rev);
        }
#pragma unroll
        for (int j = 0; j < 4; ++j) xc[j] = xn[j];
    }
}


namespace sbat {
typedef short bf16x8 __attribute__((ext_vector_type(8)));
typedef short s16x4 __attribute__((ext_vector_type(4)));
typedef float f32x16 __attribute__((ext_vector_type(16)));
typedef float f32x2_t __attribute__((ext_vector_type(2)));
typedef __bf16 bf16x2_t __attribute__((ext_vector_type(2)));
typedef unsigned u32x2 __attribute__((ext_vector_type(2)));
__device__ __forceinline__ unsigned cvtpk(float lo, float hi) { f32x2_t v = {lo, hi}; bf16x2_t b = __builtin_convertvector(v, bf16x2_t); return __builtin_bit_cast(unsigned, b); }
constexpr int KROW = 144, VROW = 144, KT_BYTES = 64 * KROW, VT_BYTES = 64 * VROW, BUF_BYTES = KT_BYTES + VT_BYTES;
#define SB_MFMA(a, b, c) __builtin_amdgcn_mfma_f32_32x32x16_bf16((a), (b), (c), 0, 0, 0)
template <bool MASKED>
__device__ __forceinline__ void local_scan(const f32x16& S, float (&d)[16], float& T, int kpos0, int qpos) {
    float kp[16];
#pragma unroll
    for (int r = 0; r < 16; ++r) {
        const float e = __builtin_amdgcn_exp2f(S[r]);
        float k = __builtin_amdgcn_rcpf(1.0f + e);
        if (MASKED) k = (kpos0 + r < qpos) ? k : 1.0f;
        kp[r] = k;
    }
    float c = 1.0f;
#pragma unroll
    for (int r = 15; r >= 0; --r) { const float cn = c * kp[r]; d[r] = c - cn; c = cn; }
    T = c;
}
constexpr int WV_ROW = 80, WV_BUF = 64 * WV_ROW, WK_ROW = 144, WK_BUF = 32 * WK_ROW, WV_BYTES = WV_BUF + WK_BUF;
__device__ __forceinline__ void sb_attn(const bf16* QKV, bf16* O, LAS unsigned char* lds, int tid) {
    const int lane = tid & 63, wave = __builtin_amdgcn_readfirstlane(tid >> 6), l32 = lane & 31, hi = lane >> 5;
    const int vdc = lane & 7, vkg = lane >> 3;
    LAS unsigned char* vimg = lds + wave * WV_BYTES; LAS unsigned char* kimg = vimg + WV_BUF;
    const int gw = blockIdx.x * NWAVES + wave, NGW = gridDim.x * NWAVES;
    for (int u = gw; u < BATCH * 16 * (SEQ / 32); u += NGW) {
        const int qblk = u & 127, bh = u >> 7, b = bh >> 4, h = bh & 15;
        const size_t tok0 = (size_t)b * SEQ;
        const int qr0 = qblk * 32, qpos = qr0 + l32;
        bf16x8 qf[4], kn[4]; v4u vreg[4];
        const bf16* const Qh = QKV + (size_t)(b * 48 + h) * SEQ * 64; const bf16* const Kh = QKV + (size_t)(b * 48 + 16 + h) * SEQ * 64; const bf16* const Vh = QKV + (size_t)(b * 48 + 32 + h) * SEQ * 64;
        { const bf16* qp = Qh + (size_t)(qr0 + l32) * 64 + 8 * hi;
#pragma unroll
          for (int ks = 0; ks < 4; ++ks) qf[ks] = *(const bf16x8*)(qp + 16 * ks); }
#define SBW_LOAD(sb_) do { const bf16* kp_ = Kh + (size_t)(32 * (sb_) + vkg) * 64 + 8 * vdc; \
            _Pragma("unroll") for (int j_ = 0; j_ < 4; ++j_) kn[j_] = *(const bf16x8*)(kp_ + (size_t)(8 * j_) * 64); \
            _Pragma("unroll") for (int i_ = 0; i_ < 4; ++i_) vreg[i_] = *(const v4u*)(Vh + (size_t)(32 * (sb_) + 4 * vkg + i_) * 64 + 8 * vdc); } while (0)
        SBW_LOAD(qblk);
        f32x16 o0, o1;
#pragma unroll
        for (int r = 0; r < 16; ++r) { o0[r] = 0.f; o1[r] = 0.f; }
        float carry = 1.0f;
        int p = 0;
        for (int sb = qblk; sb >= 0; --sb) {
            LAS unsigned char* vb = vimg;
#pragma unroll
            for (int j = 0; j < 4; ++j) *(LAS bf16x8*)(kimg + (8 * (2 * (j & 1) + (vkg >> 2)) + 4 * (j >> 1) + (vkg & 3)) * WK_ROW + 16 * vdc) = kn[j];
#pragma unroll
            for (int j = 0; j < 4; ++j) {
                const unsigned w0 = vreg[0][j], w1 = vreg[1][j], w2 = vreg[2][j], w3 = vreg[3][j];
                const u32x2 e = {(w0 & 0xffffu) | (w1 << 16), (w2 & 0xffffu) | (w3 << 16)};
                const u32x2 o = {(w0 >> 16) | (w1 & 0xffff0000u), (w2 >> 16) | (w3 & 0xffff0000u)};
                *(LAS u32x2*)(vb + (8 * vdc + 2 * j) * WV_ROW + 8 * vkg) = e; *(LAS u32x2*)(vb + (8 * vdc + 2 * j + 1) * WV_ROW + 8 * vkg) = o;
            }
            if (sb > 0) SBW_LOAD(sb - 1);
            f32x16 S;
#pragma unroll
            for (int r = 0; r < 16; ++r) S[r] = 0.f;
#pragma unroll
            for (int ks = 0; ks < 4; ++ks) { const bf16x8 kc = *(const LAS bf16x8*)(kimg + l32 * WK_ROW + 32 * ks + 16 * hi); S = SB_MFMA(kc, qf[ks], S); }
            float d[16], T;
            if (sb == qblk) local_scan<true>(S, d, T, 32 * sb + 16 * hi, qpos); else local_scan<false>(S, d, T, 0, 0);
            unsigned tb = __builtin_bit_cast(unsigned, T);
            asm volatile("" : "+v"(tb));
            const auto sw = __builtin_amdgcn_permlane32_swap(__builtin_bit_cast(unsigned, T), tb, false, false);
            const unsigned ulo = sw[0], uhi = sw[1];
            const float tlo = __builtin_bit_cast(float, ulo), thi = __builtin_bit_cast(float, uhi);
            const float R = hi ? carry : carry * thi;
            carry = carry * (tlo * thi);
            unsigned pw[8];
#pragma unroll
            for (int i = 0; i < 8; ++i) pw[i] = cvtpk(d[2 * i] * R, d[2 * i + 1] * R);
            __builtin_amdgcn_wave_barrier();
#pragma unroll
            for (int kk = 0; kk < 2; ++kk) {
                const v4u pv = {pw[4 * kk], pw[4 * kk + 1], pw[4 * kk + 2], pw[4 * kk + 3]};
                const bf16x8 pb = __builtin_bit_cast(bf16x8, pv);
                const bf16x8 a0 = *(const LAS bf16x8*)(vb + l32 * WV_ROW + (16 * hi + 8 * kk) * 2), a1 = *(const LAS bf16x8*)(vb + (32 + l32) * WV_ROW + (16 * hi + 8 * kk) * 2);
                o0 = SB_MFMA(a0, pb, o0); o1 = SB_MFMA(a1, pb, o1);
            }
            p ^= 1;
            if (__builtin_amdgcn_ballot_w64(carry >= 9.094947017729282e-13f) == 0ull) break;
        }
#undef SBW_LOAD
        {
            bf16* op = O + (tok0 + qr0 + l32) * D + h * 64 + 8 * hi;
#pragma unroll
            for (int oh = 0; oh < 2; ++oh)
#pragma unroll
                for (int k = 0; k < 2; ++k) {
                    const f32x16& ov = oh ? o1 : o0; const int g = 2 * k;
                    unsigned a0 = cvtpk(ov[4 * g], ov[4 * g + 1]), a1 = cvtpk(ov[4 * g + 2], ov[4 * g + 3]), b0 = cvtpk(ov[4 * g + 4], ov[4 * g + 5]), b1 = cvtpk(ov[4 * g + 6], ov[4 * g + 7]);
                    const auto r0 = __builtin_amdgcn_permlane32_swap(a0, b0, false, false); a0 = r0[0]; b0 = r0[1];
                    const auto r1 = __builtin_amdgcn_permlane32_swap(a1, b1, false, false); a1 = r1[0]; b1 = r1[1];
                    const v4u w = {a0, a1, b0, b1};
                    *(v4u*)(op + 32 * oh + 16 * k) = w;
                }
        }
    }
}
}


namespace swat {
using sbat::bf16x8; using sbat::f32x16; using sbat::u32x2; using sbat::cvtpk;
constexpr int KROW = 144, VROW = 520, K_BYTES = 256 * KROW, V_BYTES = 64 * VROW;
__device__ __forceinline__ void halves(float v, float& lo, float& up) {
    unsigned a = __builtin_bit_cast(unsigned, v), b = a; asm volatile("" : "+v"(b));
    const auto r = __builtin_amdgcn_permlane32_swap(a, b, false, false);
    const unsigned r0 = r[0], r1 = r[1];
    lo = __builtin_bit_cast(float, r0); up = __builtin_bit_cast(float, r1);
}
__device__ __forceinline__ void unpack8(const v4u w, float* v) { v[0] = bf_lo(w.x); v[1] = bf_hi(w.x); v[2] = bf_lo(w.y); v[3] = bf_hi(w.y); v[4] = bf_lo(w.z); v[5] = bf_hi(w.z); v[6] = bf_lo(w.w); v[7] = bf_hi(w.w); }
__device__ __forceinline__ void sw_attn(const bf16* QKV, const float* rope, const float* qg, const float* kg, const float* sinks, bf16* O, LAS unsigned char* lds, int tid) {
    const int lane = tid & 63, wave = __builtin_amdgcn_readfirstlane(tid >> 6), l32 = lane & 31, hi = lane >> 5;
    LAS unsigned char* kl = lds; LAS unsigned char* vl = lds + K_BYTES;
    constexpr float QS = 0.125f * 1.4426950408889634f;
    LAS float* gtab = (LAS float*)(lds + K_BYTES + V_BYTES);
    if (tid < 64) gtab[tid] = qg[tid];
    for (int u = blockIdx.x; u < 512; u += gridDim.x) {
        const int blk = u & 31, kvh = (u >> 5) & 1, b = u >> 6;
        const size_t tok0 = (size_t)b * SEQ;
        __syncthreads();
        v4u qraw[4]; f32x4 rraw[4];
#define SW_LOADQ(p_) do { const int T_ = wave + 8 * (p_), tb_ = T_ & 3, hq_ = kvh * 8 + (T_ >> 2); const size_t qrow_ = tok0 + blk * 128 + tb_ * 32 + l32; \
            const bf16* qp_ = QKV + ((size_t)(b * 20 + hq_) * SEQ + blk * 128 + tb_ * 32 + l32) * 64 + 8 * hi; const f32x4* rp_ = (const f32x4*)(rope + qrow_ * 16); \
            _Pragma("unroll") for (int ks_ = 0; ks_ < 4; ++ks_) { qraw[ks_] = *(const v4u*)(qp_ + 16 * ks_); rraw[ks_] = rp_[ks_]; } } while (0)
        SW_LOADQ(0);
        {
            const int row = tid >> 1, half = tid & 1, kpos = blk * 128 - 128 + row;
            v4u outw[4];
            if (kpos >= 0) {
                const bf16* kp = QKV + ((size_t)(b * 20 + 16 + kvh) * SEQ + kpos) * 64 + 32 * half;
                float v[32];
#pragma unroll
                for (int c = 0; c < 4; ++c) unpack8(*(const v4u*)(kp + 8 * c), v + 8 * c);
                float ss = 0.f;
#pragma unroll
                for (int d = 0; d < 32; ++d) ss = fmaf(v[d], v[d], ss);
                ss += pg8::shx(ss, lane, 1);
                const float rs = __builtin_amdgcn_rsqf(ss * (1.0f / 64.0f) + 1e-6f);
#pragma unroll
                for (int d = 0; d < 32; ++d) v[d] = v[d] * rs * kg[32 * half + d];
                if (half == 0) { const float* rp = rope + (tok0 + kpos) * 16;
#pragma unroll
                    for (int i = 0; i < 8; ++i) { const float c = rp[i], s = rp[8 + i], x1 = v[i], x2 = v[8 + i]; v[i] = x1 * c - x2 * s; v[8 + i] = x2 * c + x1 * s; } }
#pragma unroll
                for (int c = 0; c < 4; ++c) outw[c] = (v4u){cvtpk(v[8 * c], v[8 * c + 1]), cvtpk(v[8 * c + 2], v[8 * c + 3]), cvtpk(v[8 * c + 4], v[8 * c + 5]), cvtpk(v[8 * c + 6], v[8 * c + 7])};
            } else {
#pragma unroll
                for (int c = 0; c < 4; ++c) outw[c] = (v4u){0u, 0u, 0u, 0u};
            }
#pragma unroll
            for (int c = 0; c < 4; ++c) *(LAS v4u*)(kl + row * KROW + 64 * half + 16 * c) = outw[c];
        }
        {
            const int vdc = tid & 7, vkg = tid >> 3, kpos0 = blk * 128 - 128 + 4 * vkg;
            v4u vreg[4];
#pragma unroll
            for (int i = 0; i < 4; ++i) vreg[i] = kpos0 >= 0 ? *(const v4u*)(QKV + ((size_t)(b * 20 + 18 + kvh) * SEQ + kpos0 + i) * 64 + 8 * vdc) : (v4u){0u, 0u, 0u, 0u};
#pragma unroll
            for (int j = 0; j < 4; ++j) {
                const unsigned w0 = vreg[0][j], w1 = vreg[1][j], w2 = vreg[2][j], w3 = vreg[3][j];
                const u32x2 e = {(w0 & 0xffffu) | (w1 << 16), (w2 & 0xffffu) | (w3 << 16)};
                const u32x2 o = {(w0 >> 16) | (w1 & 0xffff0000u), (w2 >> 16) | (w3 & 0xffff0000u)};
                *(LAS u32x2*)(vl + (8 * vdc + 2 * j) * VROW + 8 * vkg) = e; *(LAS u32x2*)(vl + (8 * vdc + 2 * j + 1) * VROW + 8 * vkg) = o;
            }
        }
        __syncthreads();
        for (int p = 0; p < 4; ++p) {
            const int T = wave + 8 * p, tb = T & 3, g = T >> 2, hq = kvh * 8 + g;
            const size_t qrow = tok0 + blk * 128 + tb * 32 + l32;
            bf16x8 qf[4];
            {
                float qv[4][8]; float ss = 0.f;
#pragma unroll
                for (int ks = 0; ks < 4; ++ks) { unpack8(qraw[ks], qv[ks]);
#pragma unroll
                    for (int i = 0; i < 8; ++i) ss = fmaf(qv[ks][i], qv[ks][i], ss); }
                { float lo_, up_; halves(ss, lo_, up_); ss = lo_ + up_; }
                const float rs = __builtin_amdgcn_rsqf(ss * (1.0f / 64.0f) + 1e-6f);
#pragma unroll
                for (int ks = 0; ks < 4; ++ks) { const f32x4 g0 = *(const LAS f32x4*)(gtab + 16 * ks + 8 * hi), g1 = *(const LAS f32x4*)(gtab + 16 * ks + 8 * hi + 4);
#pragma unroll
                    for (int i = 0; i < 8; ++i) qv[ks][i] = qv[ks][i] * rs * (i < 4 ? g0[i & 3] : g1[i & 3]); }
#pragma unroll
                for (int i = 0; i < 8; ++i) { float lo_, up_; const float own = qv[0][i]; halves(own, lo_, up_); const float oth = hi ? lo_ : up_, c = i < 4 ? rraw[0][i & 3] : rraw[1][i & 3], sn = i < 4 ? rraw[2][i & 3] : rraw[3][i & 3]; qv[0][i] = own * c + oth * (hi ? sn : -sn); }
#pragma unroll
                for (int ks = 0; ks < 4; ++ks) { const v4u w = {cvtpk(qv[ks][0] * QS, qv[ks][1] * QS), cvtpk(qv[ks][2] * QS, qv[ks][3] * QS), cvtpk(qv[ks][4] * QS, qv[ks][5] * QS), cvtpk(qv[ks][6] * QS, qv[ks][7] * QS)}; qf[ks] = __builtin_bit_cast(bf16x8, w); }
            }
            if (p < 3) SW_LOADQ(p + 1);
            const float sink = sinks[hq] * 1.4426950408889634f;
            f32x16 s[5]; float mx = sink;
            const float NEG = -__builtin_inff();
#pragma unroll
            for (int js = 0; js < 5; ++js) {
#pragma unroll
                for (int r = 0; r < 16; ++r) s[js][r] = 0.f;
                const bool live = !(blk == 0 && tb + js < 4);
                if (live) {
#pragma unroll
                    for (int ks = 0; ks < 4; ++ks) { const bf16x8 a = *(const LAS bf16x8*)(kl + (32 * (tb + js) + l32) * KROW + 32 * ks + 16 * hi); s[js] = SB_MFMA(a, qf[ks], s[js]); }
#pragma unroll
                    for (int r = 0; r < 16; ++r) {
                        const int kk = (r & 3) + 8 * (r >> 2) + 4 * hi;
                        float v = s[js][r];
                        if (js == 0) v = (kk > l32) ? v : NEG;
                        if (js == 4) v = (kk <= l32) ? v : NEG;
                        s[js][r] = v; mx = fmaxf(mx, v);
                    }
                } else {
#pragma unroll
                    for (int r = 0; r < 16; ++r) s[js][r] = NEG;
                }
                asm volatile("" ::: "memory");
            }
            { float lo_, up_; halves(mx, lo_, up_); mx = fmaxf(lo_, up_); }
            float l = 0.f;
            f32x16 o0, o1;
#pragma unroll
            for (int r = 0; r < 16; ++r) { o0[r] = 0.f; o1[r] = 0.f; }
#pragma unroll
            for (int js = 0; js < 5; ++js) {
                unsigned pw[8];
#pragma unroll
                for (int r = 0; r < 16; r += 2) { const float p0 = __builtin_amdgcn_exp2f(s[js][r] - mx), p1 = __builtin_amdgcn_exp2f(s[js][r + 1] - mx); l += p0 + p1; pw[r >> 1] = cvtpk(p0, p1); }
#pragma unroll
                for (int kk = 0; kk < 2; ++kk) {
                    const v4u pv = {pw[4 * kk], pw[4 * kk + 1], pw[4 * kk + 2], pw[4 * kk + 3]};
                    const bf16x8 pb = __builtin_bit_cast(bf16x8, pv);
#pragma unroll
                    for (int dh = 0; dh < 2; ++dh) {
                        const LAS unsigned char* vp = vl + (32 * dh + l32) * VROW + (32 * (tb + js) + 16 * kk + 4 * hi) * 2;
                        const u32x2 lo = *(const LAS u32x2*)vp, hi2 = *(const LAS u32x2*)(vp + 16);
                        const v4u av = {lo[0], lo[1], hi2[0], hi2[1]};
                        const bf16x8 a = __builtin_bit_cast(bf16x8, av);
                        if (dh == 0) o0 = SB_MFMA(a, pb, o0); else o1 = SB_MFMA(a, pb, o1);
                    }
                }
                asm volatile("" ::: "memory");
            }
            { float lo_, up_; halves(l, lo_, up_); l = lo_ + up_; }
            l += __builtin_amdgcn_exp2f(sink - mx);
            const float il = 1.0f / l;
            bf16* op = O + qrow * D + hq * 64 + 4 * hi;
#pragma unroll
            for (int gg = 0; gg < 4; ++gg) {
                const u32x2 a = {cvtpk(o0[4 * gg] * il, o0[4 * gg + 1] * il), cvtpk(o0[4 * gg + 2] * il, o0[4 * gg + 3] * il)}, c = {cvtpk(o1[4 * gg] * il, o1[4 * gg + 1] * il), cvtpk(o1[4 * gg + 2] * il, o1[4 * gg + 3] * il)};
                *(u32x2*)(op + 8 * gg) = a; *(u32x2*)(op + 32 + 8 * gg) = c; }
        }
    }
}
#undef SW_LOADQ
}

#define XB_TMO      128
#define XB_XCNT(j)  (256  + 64 * (j))
#define XB_XSUB(j)  (1280 + 64 * (j))
#define XB_XGEN(j)  (2304 + 64 * (j))
#define XB_TOP      3328
#define XB_TOPGEN   3392
#define XCD_BAR_WORDS 3456
#define XB_SPIN_CAP (1u << 18)

__device__ __forceinline__ unsigned xb_ld(unsigned* p)              { return __hip_atomic_load(p, __ATOMIC_RELAXED, __HIP_MEMORY_SCOPE_AGENT); }
__device__ __forceinline__ unsigned xb_add(unsigned* p, unsigned v) { return __hip_atomic_fetch_add(p, v, __ATOMIC_RELAXED, __HIP_MEMORY_SCOPE_AGENT); }
__device__ __forceinline__ unsigned xb_xcc_id() { return (unsigned)__builtin_amdgcn_s_getreg((3 << 11) | 20) & 0xFu; }
#define XB_SPIN(cond, bar) do { unsigned _sp = 0; while (cond) { __builtin_amdgcn_s_sleep(1); \
    if ((++_sp & 255u) == 0u) { if (xb_ld(&(bar)[XB_TMO])) break; if (_sp > XB_SPIN_CAP) { atomicAdd(&(bar)[XB_TMO], 1u); break; } } } } while (0)

struct XcdBarrier {
    unsigned* bar; unsigned x;
    volatile LAS unsigned* st;
};

__device__ __forceinline__ XcdBarrier xcd_barrier_post(unsigned* bar, volatile LAS unsigned* st) {
    XcdBarrier b; b.bar = bar; b.x = xb_xcc_id(); b.st = st;
    if (threadIdx.x == 0) (void)xb_add(&bar[XB_XCNT(b.x)], 1u);
    return b;
}
__device__ __forceinline__ void xcd_barrier_complete(unsigned* bar, unsigned x, unsigned& nloc, unsigned& nx) {
    const unsigned G = gridDim.x * gridDim.y * gridDim.z;
    unsigned sum, cnt, mine, sp = 0u;
    for (;;) {
        sum = 0u; cnt = 0u; mine = 0u;
#pragma unroll
        for (unsigned j = 0; j < 16; ++j) { const unsigned c = xb_ld(&bar[XB_XCNT(j)]); sum += c; cnt += (c > 0u) ? 1u : 0u; mine = (j == x) ? c : mine; }
        if (sum == G) break;
        __builtin_amdgcn_s_sleep(1);
        if ((++sp & 255u) == 0u) { if (xb_ld(&bar[XB_TMO])) break; if (sp > XB_SPIN_CAP) { atomicAdd(&bar[XB_TMO], 1u); break; } }
    }
    nloc = mine > 0u ? mine : 1u; nx = cnt > 0u ? cnt : 1u;
}

__device__ __forceinline__ void xcd_barrier(const XcdBarrier& b) {
    asm volatile("s_waitcnt vmcnt(0)" ::: "memory");
    __syncthreads();
    if (threadIdx.x == 0) {
        unsigned* bar = b.bar;
        __builtin_amdgcn_s_waitcnt(0);
        unsigned nloc = b.st[0], nx = b.st[1];
        if (nloc == 0u) { xcd_barrier_complete(bar, b.x, nloc, nx); b.st[0] = nloc; b.st[1] = nx; }
        const unsigned old = xb_add(&bar[XB_XSUB(b.x)], 1u);
        const unsigned gen = old / nloc;
        if (old + 1u == (gen + 1u) * nloc) {
            __builtin_amdgcn_fence(__ATOMIC_RELEASE, "agent");
            asm volatile("s_waitcnt vmcnt(0)" ::: "memory");
            const unsigned og = xb_add(&bar[XB_TOP], 1u);
            const unsigned tg = og / nx;
            if (og + 1u == (tg + 1u) * nx) xb_add(&bar[XB_TOPGEN], 1u);
            else XB_SPIN(xb_ld(&bar[XB_TOPGEN]) == tg, bar);
            __builtin_amdgcn_fence(__ATOMIC_ACQUIRE, "agent");
            xb_add(&bar[XB_XGEN(b.x)], 1u);
            asm volatile("s_waitcnt vmcnt(0)" ::: "memory");
        } else {
            XB_SPIN(xb_ld(&bar[XB_XGEN(b.x)]) == gen, bar);
            __builtin_amdgcn_fence(__ATOMIC_ACQUIRE, "agent");
            asm volatile("s_waitcnt vmcnt(0)" ::: "memory");
        }
    }
    __syncthreads();
}

template <class Sched>
__device__ __forceinline__ pg8::RstdTab fill_rstd_table(const Sched& S, const float* part, LAS unsigned char* lds, int tid) {
    LAS float* tab = (LAS float*)(lds + 131072);
    pg8::RstdTab rt{tab, -1, -1, -1, -1}; int n = 0; pg8::Unit uu;
    for (int i = 0; S.next(i, uu); ++i) {
        if (uu.pm == rt.p0 || uu.pm == rt.p1 || uu.pm == rt.p2 || uu.pm == rt.p3 || n >= 4) continue;
        if (tid < 256) tab[n * 256 + tid] = pg8::row_rstd(part, uu.pm * 256 + tid);
        if (n == 0) rt.p0 = uu.pm; else if (n == 1) rt.p1 = uu.pm; else if (n == 2) rt.p2 = uu.pm; else rt.p3 = uu.pm;
        ++n;
    }
    __syncthreads();
    return rt;
}

constexpr int NPHASES = 1 + 7 * DEPTH;
#ifndef RPT_GU
#define RPT_GU 1
#endif
#ifndef RPT_QKV
#define RPT_QKV 1
#endif
#ifndef RPT_SB
#define RPT_SB 1
#endif
#ifndef RPT_SW
#define RPT_SW 1
#endif
#ifndef RPT_SYNC
#define RPT_SYNC 1
#endif
#ifndef RPT_DOWN
#define RPT_DOWN 1
#endif
#ifndef RPT_WOUT
#define RPT_WOUT 1
#endif
#ifndef RPT_PRO
#define RPT_PRO 1
#endif
__global__ void __launch_bounds__(NTHR, 2) fwd_megakernel(Args a) {
    extern __shared__ __attribute__((aligned(16))) unsigned char lds[];
    cg::grid_group grid = cg::this_grid();
    LAS unsigned char* ldsl = (LAS unsigned char*)lds;
    unsigned char* ws = a.ws;
    bf16* XB = (bf16*)(ws + WS_XB); unsigned char* XL = ws + WS_XL; float* part = (float*)(ws + WS_PART); float* rope = (float*)(ws + WS_ROPE);
    bf16* ACT = (bf16*)(ws + WS_ACT); bf16* QKV = (bf16*)(ws + WS_QKV); bf16* OB = (bf16*)(ws + WS_O);
    volatile LAS unsigned* MISC = (volatile LAS unsigned*)(ldsl + MISC_OFF);
    if (threadIdx.x < 32) MISC[threadIdx.x] = 0u;
    __syncthreads();
    XcdBarrier bar = xcd_barrier_post((unsigned*)(ws + WS_CTL), MISC + 8);
    int ph0 = a.ph_lo; const int ph1 = a.ph_hi;
    float* const outp = a.out;
    if (ph0 == 0) {
        int tid = threadIdx.x; asm volatile("" : "+v"(tid));
        for (int rep = 0; rep < RPT_PRO; ++rep) prologue(a, ldsl, __builtin_amdgcn_readfirstlane(tid >> 6), tid & 63);
        ph0 = 1;
        if (ph0 < ph1) grid.sync();
    }
    const float* small = (const float*)(ws + WS_SMALL);
    for (int ph = ph0; ph < ph1; ++ph) {
        int tid = threadIdx.x; asm volatile("" : "+v"(tid));
        {
            const int l = (ph - 1) / 7, k = (ph - 1) % 7, slot = l >> 1; const bool sb = (l & 1) == 0;
            if (k == 0 || k == 5) {
                const int j = k == 0 ? 0 : 1;
                pg8::Gemm g{XB, (const bf16*)(ws + WS_WGU) + (size_t)(l * 2 + j) * NGU * D, M, NGU, D}; pg8::StaticOrder S; S.init(M, NGU, gridDim.x, blockIdx.x);
                const pg8::RstdTab rt = fill_rstd_table(S, part, ldsl, tid);
                pg8::EpiAct E{ACT, FF, rt};
                for (int rep = 0; rep < RPT_GU; ++rep) pg8::gemm_phase<pg8::EpiAct, pg8::StaticOrder, true, true>(ldsl, g, S, E);
            } else if (k == 1 || k == 6) {
                const int j = k == 1 ? 0 : 1;
                pg8::Gemm g{ACT, (const bf16*)(ws + WS_WD) + (size_t)(l * 2 + j) * D * FF, M, D, FF}; pg8::StaticOrder S; S.init(M, D, gridDim.x, blockIdx.x);
                for (int rep = 0; rep < RPT_DOWN; ++rep) { pg8::EpiRes E{XB, XL, part, (ph == NPHASES - 1 && rep == RPT_DOWN - 1) ? outp : nullptr, rep == RPT_DOWN - 1 ? 0.5f : 0.0f};
                pg8::gemm_phase<pg8::EpiRes, pg8::StaticOrder, true, true>(ldsl, g, S, E); }
            } else if (k == 2) {
                const int N = sb ? SBN : SWN;
                pg8::Gemm g{XB, sb ? (const bf16*)(ws + WS_SBIN) + (size_t)slot * SBN * D : (const bf16*)(ws + WS_SWIN) + (size_t)slot * SWN * D, M, N, D};
                pg8::StaticOrder S; S.init(M, N, gridDim.x, blockIdx.x);
                const pg8::RstdTab rt = fill_rstd_table(S, part, ldsl, tid);
                pg8::EpiStore E{QKV, N, rt, sb ? 1024 : 0, 0.125f * 1.4426950408889634f};
                for (int rep = 0; rep < RPT_QKV; ++rep) pg8::gemm_phase<pg8::EpiStore, pg8::StaticOrder, true, true>(ldsl, g, S, E);
            } else if (k == 3) {
                if (sb) { for (int rep = 0; rep < RPT_SB; ++rep) sbat::sb_attn(QKV, OB, ldsl, tid); }
                else for (int rep = 0; rep < RPT_SW; ++rep) swat::sw_attn(QKV, rope, small + slot * HD, small + 128 + slot * HD, small + 256 + slot * 16, OB, ldsl, tid);
            } else {
                pg8::Gemm g{OB, sb ? (const bf16*)(ws + WS_SBOUT) + (size_t)slot * D * D : (const bf16*)(ws + WS_SWOUT) + (size_t)slot * D * D, M, D, D};
                pg8::StaticOrder S; S.init(M, D, gridDim.x, blockIdx.x);
                for (int rep = 0; rep < RPT_WOUT; ++rep) { pg8::EpiRes E{XB, XL, part, nullptr, rep == RPT_WOUT - 1 ? 1.0f : 0.0f};
                pg8::gemm_phase<pg8::EpiRes, pg8::StaticOrder, true, true>(ldsl, g, S, E); }
            }
        }
        if (ph + 1 < ph1) { for (int rep = 0; rep < RPT_SYNC; ++rep) xcd_barrier(bar); }
    }
}

#ifndef MK_PER_PHASE
#define MK_PER_PHASE 0
#endif
extern "C" void kernel_launch(void* const* d_in, const int* in_sizes, int n_in, void* d_out, int out_size, void* d_ws, size_t ws_size, hipStream_t stream) {
    static int grid = 0;
    if (grid == 0) {
        if (n_in != 12 || in_sizes[0] != M * D || out_size != M * D || ws_size < WS_END) { fprintf(stderr, "kernel_launch: unexpected shapes (n_in %d, ws %zu)\n", n_in, ws_size); grid = -1; return; }
        int dev = 0, cus = 0, per_cu = 0;
        hipGetDevice(&dev); hipDeviceGetAttribute(&cus, hipDeviceAttributeMultiprocessorCount, dev);
        if (hipFuncSetAttribute((const void*)fwd_megakernel, hipFuncAttributeMaxDynamicSharedMemorySize, LDS_BYTES) != hipSuccess) { fprintf(stderr, "kernel_launch: hipFuncSetAttribute failed\n"); grid = -1; return; }
        if (hipOccupancyMaxActiveBlocksPerMultiprocessor(&per_cu, (const void*)fwd_megakernel, NTHR, LDS_BYTES) != hipSuccess || per_cu < 1) { fprintf(stderr, "kernel_launch: occupancy query says %d\n", per_cu); per_cu = 1; }
        (void)hipGetLastError();
        grid = cus * 1;
    }
    if (grid < 0) return;
    if (hipMemsetAsync((char*)d_ws + WS_CTL, 0, CTL_ZERO_BYTES, stream) != hipSuccess) { fprintf(stderr, "kernel_launch: memset failed\n"); return; }
    Args a{};
    a.x = (const float*)d_in[0]; a.pos = (const int*)d_in[1]; a.gains = (const float*)d_in[2]; a.wgu = (const float*)d_in[3]; a.wd = (const float*)d_in[4];
    a.sbin = (const float*)d_in[5]; a.sbout = (const float*)d_in[6]; a.swin = (const float*)d_in[7]; a.swout = (const float*)d_in[8];
    a.qg = (const float*)d_in[9]; a.kg = (const float*)d_in[10]; a.sinks = (const float*)d_in[11];
    a.out = (float*)d_out; a.ws = (unsigned char*)d_ws;
#if MK_PER_PHASE
    for (int ph = 0; ph < NPHASES; ++ph) { a.ph_lo = ph; a.ph_hi = ph + 1; hipLaunchKernelGGL(fwd_megakernel, dim3(grid), dim3(NTHR), LDS_BYTES, stream, a); }
#else
    a.ph_lo = 0; a.ph_hi = NPHASES;
    void* args[] = {&a};
    hipError_t e = hipLaunchCooperativeKernel((const void*)fwd_megakernel, dim3(grid), dim3(NTHR), args, LDS_BYTES, stream);
    if (e != hipSuccess) fprintf(stderr, "cooperative launch failed: %s (grid %d)\n", hipGetErrorString(e), grid);
#endif
}
```
